# Optimizing an MI355X kernel written in HIP

```python
import jax
import jax.numpy as jnp
from jax import lax
import numpy as np

D_MODEL = 1024
BATCH = 16
SEQ = 256
DEPTH = 4
DEC_BATCH = 4
DEC_SEQ = 2048
PAST_LEN = 256

GRID_W = 64
HEAD_DIM = 64
NA_WIDTH = D_MODEL // 4
NA_HEADS = NA_WIDTH // HEAD_DIM
NA_WIN_R = 8
NA_WIN_C = 16
MLA_WIDTH = D_MODEL // 2
MLA_V = 64
MLA_HEADS = MLA_WIDTH // MLA_V
MLA_NOPE = 64
MLA_ROPE = 32
MLA_Q_RANK = 3 * D_MODEL // 8
MLA_KV_RANK = D_MODEL // 4
SGU_WIDTH = D_MODEL // 4
SGU_GROUPS = 4
SGU_CHUNK = 128
D_FF = 11 * D_MODEL // 4
CONV_W = 3
ROPE_THETA = 10000.0
EPS = 1e-6
Q_BLOCK = 128
NEG_INF = -1e30
NA_SCALE = HEAD_DIM ** -0.5
MLA_SCALE = (MLA_NOPE + MLA_ROPE) ** -0.5
PROJ_SIZES = (NA_WIDTH, NA_WIDTH, NA_WIDTH, MLA_Q_RANK, MLA_KV_RANK, MLA_ROPE, 2 * SGU_WIDTH)
IN_WIDTH = sum(PROJ_SIZES)

kernel_name = 'hybrid_na_mla_sgu_diffusion_step'


def rmsnorm(x, g):
    xf = x.astype(jnp.float32)
    y = xf * lax.rsqrt(jnp.mean(xf * xf, axis=-1, keepdims=True) + EPS)
    return (y * g.astype(jnp.float32)).astype(x.dtype)


def split_heads(a, n):
    return a.reshape(a.shape[:-1] + (n, a.shape[-1] // n))


def merge_heads(a):
    return a.reshape(a.shape[:-2] + (-1,))


def axial_rope_tables(n_tokens):
    t = jnp.arange(n_tokens)
    n_freq = MLA_ROPE // 4
    inv_freq = ROPE_THETA ** (-jnp.arange(n_freq, dtype=jnp.float32) / n_freq)
    ang_r = (t // GRID_W).astype(jnp.float32)[:, None] * inv_freq
    ang_c = (t % GRID_W).astype(jnp.float32)[:, None] * inv_freq
    return (jnp.cos(ang_r), jnp.sin(ang_r), jnp.cos(ang_c), jnp.sin(ang_c))


def _rotate(x, cos, sin):
    x1, x2 = jnp.split(x, 2, axis=-1)
    cos = cos.astype(x.dtype)
    sin = sin.astype(x.dtype)
    return jnp.concatenate([x1 * cos - x2 * sin, x1 * sin + x2 * cos], axis=-1)


def axial_rope(x, tables):
    cos_r, sin_r, cos_c, sin_c = tables
    x_row, x_col = jnp.split(x, 2, axis=-1)
    return jnp.concatenate([_rotate(x_row, cos_r, sin_r), _rotate(x_col, cos_c, sin_c)], axis=-1)


def blocked_attention(q, k, v, scale):
    b, tq, h, dk = q.shape
    nb = tq // Q_BLOCK
    qb = q.reshape(b, nb, Q_BLOCK, h, dk).transpose(1, 0, 2, 3, 4)

    def one_block(q_blk):
        s = jnp.einsum('bqhd,bkhd->bhqk', q_blk, k).astype(jnp.float32) * scale
        p = jax.nn.softmax(s, axis=-1).astype(v.dtype)
        return jnp.einsum('bhqk,bkhd->bqhd', p, v)

    o = lax.map(one_block, qb)
    return o.transpose(1, 0, 2, 3, 4).reshape(b, tq, h, v.shape[-1])


def neighbourhood_attention(q, k, v, k_ctx, v_ctx, rpb, rows):
    b, t, h, dh = q.shape
    kr = min(NA_WIN_R, rows)
    qg = q.reshape(b, rows, GRID_W, h, dh)
    kg = k.reshape(b, rows, GRID_W, h, dh)
    vg = v.reshape(b, rows, GRID_W, h, dh)
    r = jnp.arange(rows)
    row_idx = jnp.clip(r - kr // 2, 0, rows - kr)[:, None] + jnp.arange(kr)[None, :]
    kb = kg[:, row_idx]
    vb = vg[:, row_idx]
    cols = jnp.arange(GRID_W)
    col_start = jnp.clip(cols - NA_WIN_C // 2, 0, GRID_W - NA_WIN_C)
    col_mask = (cols[None, :] >= col_start[:, None]) & (cols[None, :] < col_start[:, None] + NA_WIN_C)
    row_off = row_idx - r[:, None] + (NA_WIN_R - 1)
    col_off = jnp.clip(cols[None, :] - cols[:, None], -(NA_WIN_C - 1), NA_WIN_C - 1) + (NA_WIN_C - 1)
    bias = rpb[:, row_off[:, None, :, None], col_off[None, :, None, :]]
    s_loc = jnp.einsum('brqhd,brkchd->bhrqkc', qg, kb).astype(jnp.float32) * NA_SCALE
    s_loc = s_loc + bias.astype(jnp.float32)[None]
    s_loc = jnp.where(col_mask[None, None, None, :, None, :], s_loc, NEG_INF)
    n_loc = kr * GRID_W
    s_loc = s_loc.reshape(b, h, rows, GRID_W, n_loc)
    s_ctx = jnp.einsum('brqhd,bkhd->bhrqk', qg, k_ctx).astype(jnp.float32) * NA_SCALE
    p = jax.nn.softmax(jnp.concatenate([s_loc, s_ctx], axis=-1), axis=-1).astype(v.dtype)
    p_loc = p[..., :n_loc].reshape(b, h, rows, GRID_W, kr, GRID_W)
    p_ctx = p[..., n_loc:]
    o = jnp.einsum('bhrqkc,brkchd->brqhd', p_loc, vb) + jnp.einsum('bhrqk,bkhd->brqhd', p_ctx, v_ctx)
    return o.reshape(b, t, h * dh)


def spatial_gating(uv, g_sgu, w_s, b_s):
    u, v = jnp.split(jax.nn.gelu(uv), 2, axis=-1)
    v = rmsnorm(v, g_sgu)
    b, t, _ = v.shape
    vc = v.reshape(b, t // SGU_CHUNK, SGU_CHUNK, SGU_GROUPS, SGU_WIDTH // SGU_GROUPS)
    mixed = jnp.einsum('gpk,bnkgd->bnpgd', w_s, vc) + b_s.T[:, :, None]
    return u * mixed.reshape(b, t, SGU_WIDTH)


def conv_ffn(h, w_in, conv_w, conv_b, w_out):
    a = h @ w_in
    t = a.shape[1]
    ap = jnp.pad(a, ((0, 0), (CONV_W // 2, CONV_W // 2), (0, 0)))
    a = sum(ap[:, i:i + t] * conv_w[i] for i in range(CONV_W)) + conv_b
    gate, val = jnp.split(a, 2, axis=-1)
    return (jax.nn.silu(gate) * val) @ w_out


def modulation(cond, w_mod, b_mod):
    m = jax.nn.silu(cond) @ w_mod + b_mod
    return jnp.split(m[:, None, :], 6, axis=-1)


def _split_proj(z):
    offs = np.cumsum(PROJ_SIZES)[:-1].tolist()
    return jnp.split(z, offs, axis=-1)


def _mla_queries(cq, g_cq, w_uq):
    q = split_heads(rmsnorm(cq, g_cq) @ w_uq, MLA_HEADS)
    return q[..., :MLA_NOPE], q[..., MLA_NOPE:]


def _mla_attend(q_nope, q_rope, ckv, k_rope, w_ukv):
    kv = split_heads(ckv @ w_ukv, MLA_HEADS)
    k_nope, v = kv[..., :MLA_NOPE], kv[..., MLA_NOPE:]
    b, tk, h, _ = k_nope.shape
    k = jnp.concatenate([k_nope, jnp.broadcast_to(k_rope[:, :, None, :], (b, tk, h, MLA_ROPE))], axis=-1)
    q = jnp.concatenate([q_nope, q_rope], axis=-1)
    return merge_heads(blocked_attention(q, k, v, MLA_SCALE))


def context_mixer(h, lp):
    qa, ka, va, cq, ckv, krope, uv = _split_proj(h @ lp['w_in'])
    qa, ka, va = split_heads(qa, NA_HEADS), split_heads(ka, NA_HEADS), split_heads(va, NA_HEADS)
    ckv = rmsnorm(ckv, lp['g_ckv'])
    o_a = merge_heads(blocked_attention(qa, ka, va, NA_SCALE))
    q_nope, q_rope = _mla_queries(cq, lp['g_cq'], lp['w_uq'])
    o_b = _mla_attend(q_nope, q_rope, ckv, krope, lp['w_ukv'])
    o_c = spatial_gating(uv, lp['g_sgu'], lp['w_sgu'], lp['b_sgu'])
    return jnp.concatenate([o_a, o_b, o_c], axis=-1), (ka, va, ckv, krope)


def latent_mixer(h, lp, ctx, rows, rope_q, rope_k):
    ka_ctx, va_ctx, ckv_ctx, krope_ctx = ctx
    qa, ka, va, cq, ckv, krope, uv = _split_proj(h @ lp['w_in'])
    qa, ka, va = split_heads(qa, NA_HEADS), split_heads(ka, NA_HEADS), split_heads(va, NA_HEADS)
    o_a = neighbourhood_attention(qa, ka, va, ka_ctx, va_ctx, lp['na_rpb'], rows)
    ckv = rmsnorm(ckv, lp['g_ckv'])
    q_nope, q_rope = _mla_queries(cq, lp['g_cq'], lp['w_uq'])
    q_rope = axial_rope(q_rope, rope_q)
    krope = axial_rope(krope, rope_k)
    o_b = _mla_attend(q_nope, q_rope, jnp.concatenate([ckv_ctx, ckv], axis=1),
                      jnp.concatenate([krope_ctx, krope], axis=1), lp['w_ukv'])
    o_c = spatial_gating(uv, lp['g_sgu'], lp['w_sgu'], lp['b_sgu'])
    return jnp.concatenate([o_a, o_b, o_c], axis=-1), None


def residual_block(x, mods, lp, mixer):
    sh1, sc1, g1, sh2, sc2, g2 = mods
    h = rmsnorm(x, lp['g_mix']) * (1 + sc1) + sh1
    mix, ctx_tensors = mixer(h)
    x = x + g1 * (mix @ lp['w_out'])
    h = rmsnorm(x, lp['g_ffn']) * (1 + sc2) + sh2
    x = x + g2 * conv_ffn(h, lp['w_ffn_in'], lp['ffn_conv_w'], lp['ffn_conv_b'], lp['w_ffn_out'])
    return x, ctx_tensors


def setup_inputs(seed: int = 0) -> dict:
    key = jax.random.key(seed)
    ks = jax.random.split(key, 27)
    L = DEPTH

    def nrm(k, shape, s):
        return jax.random.normal(k, shape, jnp.float32) * s

    def gain(k, shape):
        return 1.0 + 0.05 * jax.random.normal(k, shape, jnp.float32)

    return {
        'x_prompt': nrm(ks[0], (BATCH, SEQ, D_MODEL), 1.0),
        'x_sample': nrm(ks[1], (DEC_BATCH, DEC_SEQ, D_MODEL), 1.0),
        'cache_na_k': nrm(ks[2], (DEC_BATCH, L, PAST_LEN, NA_HEADS, HEAD_DIM), 1.0),
        'cache_na_v': nrm(ks[3], (DEC_BATCH, L, PAST_LEN, NA_HEADS, HEAD_DIM), 1.0),
        'cache_mla_ckv': nrm(ks[4], (DEC_BATCH, L, PAST_LEN, MLA_KV_RANK), 1.0),
        'cache_mla_krope': nrm(ks[5], (DEC_BATCH, L, PAST_LEN, MLA_ROPE), 1.0),
        'c': nrm(ks[6], (DEC_BATCH, D_MODEL), 1.0),
        'c_ctx': nrm(ks[7], (D_MODEL,), 1.0),
        'w_mod': nrm(ks[8], (L, D_MODEL, 6 * D_MODEL), 0.5 * D_MODEL ** -0.5),
        'b_mod': nrm(ks[9], (L, 6 * D_MODEL), 0.02),
        'g_mix': gain(ks[10], (L, D_MODEL)),
        'w_in': nrm(ks[11], (L, D_MODEL, IN_WIDTH), D_MODEL ** -0.5),
        'na_rpb': nrm(ks[12], (L, NA_HEADS, 2 * NA_WIN_R - 1, 2 * NA_WIN_C - 1), 0.5),
        'g_cq': gain(ks[13], (L, MLA_Q_RANK)),
        'w_uq': nrm(ks[14], (L, MLA_Q_RANK, MLA_HEADS * (MLA_NOPE + MLA_ROPE)), MLA_Q_RANK ** -0.5),
        'g_ckv': gain(ks[15], (L, MLA_KV_RANK)),
        'w_ukv': nrm(ks[16], (L, MLA_KV_RANK, MLA_HEADS * (MLA_NOPE + MLA_V)), MLA_KV_RANK ** -0.5),
        'g_sgu': gain(ks[17], (L, SGU_WIDTH)),
        'w_sgu': nrm(ks[18], (L, SGU_GROUPS, SGU_CHUNK, SGU_CHUNK), SGU_CHUNK ** -0.5),
        'b_sgu': gain(ks[19], (L, SGU_GROUPS, SGU_CHUNK)),
        'w_out': nrm(ks[20], (L, D_MODEL, D_MODEL), D_MODEL ** -0.5),
        'g_ffn': gain(ks[21], (L, D_MODEL)),
        'w_ffn_in': nrm(ks[22], (L, D_MODEL, 2 * D_FF), D_MODEL ** -0.5),
        'ffn_conv_w': nrm(ks[23], (L, CONV_W, 2 * D_FF), CONV_W ** -0.5),
        'ffn_conv_b': nrm(ks[24], (L, 2 * D_FF), 0.02),
        'w_ffn_out': nrm(ks[25], (L, D_FF, D_MODEL), D_FF ** -0.5),
        'g_final': gain(ks[26], (D_MODEL,)),
    }


def reference(x_prompt, x_sample, cache_na_k, cache_na_v, cache_mla_ckv, cache_mla_krope, c, c_ctx,
              w_mod, b_mod, g_mix, w_in, na_rpb, g_cq, w_uq, g_ckv, w_ukv, g_sgu, w_sgu, b_sgu,
              w_out, g_ffn, w_ffn_in, ffn_conv_w, ffn_conv_b, w_ffn_out, g_final):
    rows = x_sample.shape[1] // GRID_W
    rope_k = axial_rope_tables(x_sample.shape[1])
    rope_q = tuple(tab[:, None, :] for tab in rope_k)
    xp, xs = x_prompt, x_sample
    new_k, new_v, new_ckv, new_kr = [], [], [], []
    for l in range(DEPTH):
        lp = {
            'g_mix': g_mix[l], 'w_in': w_in[l], 'na_rpb': na_rpb[l], 'g_cq': g_cq[l], 'w_uq': w_uq[l],
            'g_ckv': g_ckv[l], 'w_ukv': w_ukv[l], 'g_sgu': g_sgu[l], 'w_sgu': w_sgu[l], 'b_sgu': b_sgu[l],
            'w_out': w_out[l], 'g_ffn': g_ffn[l], 'w_ffn_in': w_ffn_in[l], 'ffn_conv_w': ffn_conv_w[l],
            'ffn_conv_b': ffn_conv_b[l], 'w_ffn_out': w_ffn_out[l],
        }
        mods_ctx = modulation(c_ctx[None, :], w_mod[l], b_mod[l])
        xp, (ka, va, ckv, kr) = residual_block(xp, mods_ctx, lp, lambda h: context_mixer(h, lp))
        new_k.append(ka)
        new_v.append(va)
        new_ckv.append(ckv)
        new_kr.append(kr)
        mods_lat = modulation(c, w_mod[l], b_mod[l])
        ctx_l = (cache_na_k[:, l], cache_na_v[:, l], cache_mla_ckv[:, l], cache_mla_krope[:, l])
        xs, _ = residual_block(xs, mods_lat, lp,
                               lambda h: latent_mixer(h, lp, ctx_l, rows, rope_q, rope_k))
    y_prompt = rmsnorm(xp, g_final)
    y_sample = rmsnorm(xs, g_final)
    new_na_k = jnp.stack(new_k, axis=1)
    new_na_v = jnp.stack(new_v, axis=1)
    new_mla_ckv = jnp.stack(new_ckv, axis=1)
    new_mla_krope = jnp.stack(new_kr, axis=1)
    return (y_prompt, y_sample, new_na_k, new_na_v, new_mla_ckv, new_mla_krope)
```

```cpp
#include <hip/hip_runtime.h>
#include <cstdio>
#include <cstdint>
namespace pg8 {
#define PG8_LAS __attribute__((address_space(3)))
typedef unsigned short bf16_t;
typedef short bf16x8 __attribute__((ext_vector_type(8)));
typedef float f32x4 __attribute__((ext_vector_type(4)));
typedef unsigned u32x4 __attribute__((ext_vector_type(4)));
constexpr int BM = 256, BK = 64, HALF = 128, HTB = HALF * BK * 2  , STAGE_BYTES = 8 * HTB, NXCD = 8, WGM = 8;

__host__ __device__ __forceinline__ int lds_byte(int r, int c) { const int st = (r >> 4) * 2 + (c >> 5), rr = r & 15, cc = c & 31, ob = rr * 64 + cc * 2; return st * 1024 + (ob ^ (((ob >> 9) & 1) << 5)); }
__host__ __device__ __forceinline__ void stage_rc(int b, int& R, int& C) { const int st = b / 1024, sb = b % 1024, swz = sb ^ (((sb >> 9) & 1) << 5); R = (st >> 1) * 16 + swz / 64; C = (st & 1) * 32 + (swz % 64) / 2; }
__host__ __device__ __forceinline__ int perm32(int rho) { const int n = rho >> 4, i = rho & 15; return 8 * (i >> 2) + 4 * n + (i & 3); }

struct Unit { int pm, pn; };
struct Gemm { const bf16_t* A; const bf16_t* Bt; int M, N, K; };

struct StaticOrder {
    int nM, nN, nwg, G, c;
    __host__ __device__ void init(int M, int N, int G_, int c_) { nM = M / BM; nN = N / BM; nwg = nM * nN; G = G_; c = c_; }
    __host__ __device__ bool next(int i, Unit& u) const {
        const long L = (long)i * G + c; if (L >= nwg) return false;
        int wgid = (int)L; { const int q = nwg / NXCD, r = nwg % NXCD, xcd = wgid % NXCD, off = wgid / NXCD; wgid = (xcd < r ? xcd * (q + 1) : r * (q + 1) + (xcd - r) * q) + off; }
        const int nig = WGM * nN, gid = wgid / nig, fm = gid * WGM, gsz = (nM - fm) < WGM ? (nM - fm) : WGM;
        u.pm = fm + ((wgid % nig) % gsz); u.pn = (wgid % nig) / gsz; return true;
    }
    __device__ __forceinline__ void a_ready(const Unit&) const {}
    __device__ __forceinline__ void done(const Unit&) const {}
};


__device__ __forceinline__ int pg8_lane_id_v() { int l; asm volatile("v_mbcnt_lo_u32_b32 %0, -1, 0\n\tv_mbcnt_hi_u32_b32 %0, -1, %0" : "=v"(l)); return l; }
__device__ __forceinline__ int pg8_lane_id() { return (int)__builtin_amdgcn_mbcnt_hi(~0u, __builtin_amdgcn_mbcnt_lo(~0u, 0u)); }
template <class Epi, class Sched, bool ALIGN_EPI = false, bool SP2 = false>
__device__ __forceinline__ void gemm_phase(PG8_LAS unsigned char* lds, const Gemm g, const Sched& S, const Epi& E, const int wid_in) {
    const int lane = pg8_lane_id_v(), wid = wid_in, tid = wid * 64 + lane, wr = wid >> 2, wc = wid & 3, fr = lane & 15, fq = lane >> 4;
    const int K = g.K, nt = K / BK;
    unsigned voffA[2], voffB[2];
#pragma unroll
    for (int i = 0; i < 2; ++i) { int R, C; stage_rc(tid * 16 + i * 8192, R, C); const int Rb = Epi::PERM ? ((R & ~31) + perm32(R & 31)) : R;
        voffA[i] = (unsigned)(R * K + C) * 2u; voffB[i] = (unsigned)(Rb * K + C) * 2u; }
    const size_t kstep = (size_t)(BK * 2);
    const size_t hstep = (size_t)HALF * K * 2;
    const size_t tstep = 2 * hstep;
    const unsigned ldsw = (unsigned)wid * 1024u;
    const int aoff = lds_byte(wr * 64 + fr, fq * 8), boff = lds_byte(wc * 32 + fr, fq * 8);
#define PG8_SA(b, h) (((b) * 2 + (h)) * HTB)
#define PG8_SB(b, h) ((4 + (b) * 2 + (h)) * HTB)
#define PG8_STAGE(bufoff, gbase, voff) do { _Pragma("unroll") for (int _i = 0; _i < 2; ++_i) \
        __builtin_amdgcn_global_load_lds((const unsigned*)((const char*)(gbase) + (voff)[_i]), (PG8_LAS unsigned*)(lds + (bufoff) + ldsw + _i * 8192), 16, 0, 0); } while (0)
#define PG8_LDA(dst, b, h) do { _Pragma("unroll") for (int m = 0; m < 4; ++m) _Pragma("unroll") for (int k = 0; k < 2; ++k) dst[m][k] = *(const PG8_LAS bf16x8*)(lds + PG8_SA(b, h) + aoff + m * 2048 + k * 1024); } while (0)
#define PG8_LDB(dst, b, h) do { _Pragma("unroll") for (int n = 0; n < 2; ++n) _Pragma("unroll") for (int k = 0; k < 2; ++k) dst[n][k] = *(const PG8_LAS bf16x8*)(lds + PG8_SB(b, h) + boff + n * 2048 + k * 1024); } while (0)
#define PG8_MMA(ai, bj, At, Bt) do { __builtin_amdgcn_s_setprio(1); _Pragma("unroll") for (int m = 0; m < 4; ++m) _Pragma("unroll") for (int n = 0; n < 2; ++n) _Pragma("unroll") for (int k = 0; k < 2; ++k) \
        acc[ai][bj][m][n] = __builtin_amdgcn_mfma_f32_16x16x32_bf16(Bt[n][k], At[m][k], acc[ai][bj][m][n], 0, 0, 0); __builtin_amdgcn_s_setprio(0); } while (0)
#define PG8_WAIT_V(n) asm volatile("s_waitcnt vmcnt(" #n ")" ::: "memory")
#define PG8_WAIT_L(n) asm volatile("s_waitcnt lgkmcnt(" #n ")" ::: "memory")
#define PG8_BAR __builtin_amdgcn_s_barrier()
#define PG8_SCHED __builtin_amdgcn_sched_barrier(0)
    Unit cur, nxt; int ui = 0;
    if (!S.next(0, cur)) return;
    f32x4 acc[2][2][4][2];
#pragma unroll
    for (int a = 0; a < 2; ++a)
#pragma unroll
        for (int b = 0; b < 2; ++b)
#pragma unroll
            for (int m = 0; m < 4; ++m)
#pragma unroll
                for (int n = 0; n < 2; ++n) acc[a][b][m][n] = (f32x4){0.f, 0.f, 0.f, 0.f};
    bf16x8 At[4][2], B0[2][2], B1[2][2];
    const char* cA = (const char*)g.A + (size_t)cur.pm * tstep; const char* cB = (const char*)g.Bt + (size_t)cur.pn * tstep;
    S.a_ready(cur);
    if constexpr (SP2) {
        PG8_STAGE(PG8_SB(0, 0), cB, voffB); PG8_STAGE(PG8_SB(0, 1), cB + hstep, voffB); PG8_STAGE(PG8_SA(0, 0), cA, voffA); PG8_STAGE(PG8_SA(0, 1), cA + hstep, voffA);
        if (wr == 1) PG8_BAR;
        PG8_WAIT_V(2); PG8_BAR;
        PG8_STAGE(PG8_SB(1, 0), cB + kstep, voffB); PG8_STAGE(PG8_SA(1, 0), cA + kstep, voffA); PG8_STAGE(PG8_SB(1, 1), cB + hstep + kstep, voffB);
        PG8_WAIT_V(6); PG8_BAR;
    } else {
        PG8_STAGE(PG8_SB(0, 0), cB, voffB); PG8_STAGE(PG8_SA(0, 0), cA, voffA); PG8_STAGE(PG8_SB(0, 1), cB + hstep, voffB); PG8_STAGE(PG8_SA(0, 1), cA + hstep, voffA);
        if (wr == 1) PG8_BAR;
        PG8_WAIT_V(4); PG8_BAR;
        PG8_STAGE(PG8_SB(1, 0), cB + kstep, voffB); PG8_STAGE(PG8_SA(1, 0), cA + kstep, voffA); PG8_STAGE(PG8_SB(1, 1), cB + hstep + kstep, voffB);
        PG8_WAIT_V(6); PG8_BAR;
    }
    for (;;) {
        const bool has_next = S.next(ui + 1, nxt);
        const char* nA = has_next ? (const char*)g.A + (size_t)nxt.pm * tstep : cA; const char* nB = has_next ? (const char*)g.Bt + (size_t)nxt.pn * tstep : cB;
        for (int t = 0; t < nt; t += 2) {
            const bool last = (t == nt - 2);
            const char* a1 = cA + (size_t)(t + 1) * kstep;
            const char* a2 = last ? nA : cA + (size_t)(t + 2) * kstep; const char* b2 = last ? nB : cB + (size_t)(t + 2) * kstep;
            const char* a3 = a2 + kstep; const char* b3 = b2 + kstep;
            if (last && has_next) S.a_ready(nxt);
            if constexpr (SP2) {
            PG8_LDB(B0, 0, 0); PG8_LDB(B1, 0, 1); PG8_SCHED; PG8_LDA(At, 0, 0); PG8_STAGE(PG8_SA(1, 1), a1 + hstep, voffA);
            PG8_WAIT_V(8); PG8_WAIT_L(0); PG8_BAR; PG8_MMA(0, 0, At, B0); PG8_MMA(0, 1, At, B1); PG8_BAR; PG8_SCHED;
            PG8_LDA(At, 0, 1); PG8_STAGE(PG8_SB(0, 0), b2, voffB); PG8_STAGE(PG8_SB(0, 1), b2 + hstep, voffB); PG8_STAGE(PG8_SA(0, 0), a2, voffA);
            PG8_WAIT_V(8); PG8_WAIT_L(0); PG8_BAR; PG8_MMA(1, 0, At, B0); PG8_MMA(1, 1, At, B1); PG8_BAR; PG8_SCHED;
            PG8_LDB(B0, 1, 0); PG8_LDB(B1, 1, 1); PG8_SCHED; PG8_LDA(At, 1, 0); PG8_STAGE(PG8_SA(0, 1), a2 + hstep, voffA);
            PG8_WAIT_V(8); PG8_WAIT_L(0); PG8_BAR; PG8_MMA(0, 0, At, B0); PG8_MMA(0, 1, At, B1); PG8_BAR; PG8_SCHED;
            PG8_LDA(At, 1, 1); PG8_STAGE(PG8_SB(1, 0), b3, voffB); PG8_STAGE(PG8_SB(1, 1), b3 + hstep, voffB); PG8_STAGE(PG8_SA(1, 0), a3, voffA);
            PG8_WAIT_V(8); PG8_WAIT_L(0); PG8_BAR; PG8_MMA(1, 0, At, B0); PG8_MMA(1, 1, At, B1); PG8_BAR; PG8_SCHED;
            } else {
            PG8_LDB(B0, 0, 0); PG8_SCHED; PG8_LDA(At, 0, 0); PG8_STAGE(PG8_SA(1, 1), a1 + hstep, voffA);
            PG8_WAIT_L(8); PG8_BAR; PG8_WAIT_L(0); PG8_MMA(0, 0, At, B0); PG8_BAR; PG8_SCHED;
            PG8_LDB(B1, 0, 1); PG8_STAGE(PG8_SB(0, 0), b2, voffB);
            PG8_BAR; PG8_WAIT_L(0); PG8_MMA(0, 1, At, B1); PG8_BAR;
            PG8_LDA(At, 0, 1); PG8_STAGE(PG8_SA(0, 0), a2, voffA);
            PG8_BAR; PG8_WAIT_L(0); PG8_MMA(1, 0, At, B0); PG8_BAR; PG8_SCHED;
            PG8_STAGE(PG8_SB(0, 1), b2 + hstep, voffB);
            PG8_WAIT_V(6); PG8_BAR; PG8_MMA(1, 1, At, B1); PG8_BAR;
            PG8_LDB(B0, 1, 0); PG8_SCHED; PG8_LDA(At, 1, 0); PG8_STAGE(PG8_SA(0, 1), a2 + hstep, voffA);
            PG8_WAIT_L(8); PG8_BAR; PG8_WAIT_L(0); PG8_MMA(0, 0, At, B0); PG8_BAR; PG8_SCHED;
            PG8_LDB(B1, 1, 1); PG8_STAGE(PG8_SB(1, 0), b3, voffB);
            PG8_BAR; PG8_WAIT_L(0); PG8_MMA(0, 1, At, B1); PG8_BAR;
            PG8_LDA(At, 1, 1); PG8_STAGE(PG8_SA(1, 0), a3, voffA);
            PG8_BAR; PG8_WAIT_L(0); PG8_MMA(1, 0, At, B0); PG8_BAR; PG8_SCHED;
            PG8_STAGE(PG8_SB(1, 1), b3 + hstep, voffB);
            PG8_WAIT_V(6); PG8_BAR; PG8_MMA(1, 1, At, B1); PG8_BAR;
            }
        }
        if constexpr (ALIGN_EPI) { if (wr == 0) PG8_BAR; }
        if constexpr (!Epi::AFTER_DRAIN) { const int l2 = pg8_lane_id_v(); E(acc, cur, wr, wc, l2 & 15, l2 >> 4); S.done(cur); }
        if (!has_next) break;
#pragma unroll
        for (int a = 0; a < 2; ++a)
#pragma unroll
            for (int b = 0; b < 2; ++b)
#pragma unroll
                for (int m = 0; m < 4; ++m)
#pragma unroll
                    for (int n = 0; n < 2; ++n) acc[a][b][m][n] = (f32x4){0.f, 0.f, 0.f, 0.f};
        cur = nxt; cA = nA; cB = nB; ++ui;
        if constexpr (ALIGN_EPI) { if (wr == 1) PG8_BAR; }
    }
    PG8_WAIT_V(0);
    if constexpr (!ALIGN_EPI) { if (wr == 0) PG8_BAR; }
    PG8_BAR;
    if constexpr (Epi::AFTER_DRAIN) { E.fused(acc, cur, wr, wc, fr, fq, lds, wid, lane); S.done(cur); }
#undef PG8_SA
#undef PG8_SB
#undef PG8_STAGE
#undef PG8_LDA
#undef PG8_LDB
#undef PG8_MMA
#undef PG8_WAIT_V
#undef PG8_WAIT_L
#undef PG8_BAR
#undef PG8_SCHED
}
}

#define GAS __attribute__((address_space(1)))
#define LAS __attribute__((address_space(3)))
typedef unsigned short bf16;
typedef unsigned v4u __attribute__((ext_vector_type(4)));
typedef float f32x4 __attribute__((ext_vector_type(4)));
typedef short bf16x8 __attribute__((ext_vector_type(8)));
typedef GAS unsigned gu32;
typedef GAS unsigned long long gu64;
#define RLX_AGENT __ATOMIC_RELAXED, __HIP_MEMORY_SCOPE_AGENT
#define LDS_WAIT() asm volatile("s_waitcnt lgkmcnt(0)" ::: "memory")
#define VM_WAIT() asm volatile("s_waitcnt vmcnt(0)" ::: "memory")
__device__ __forceinline__ unsigned long long rt() { return __builtin_amdgcn_s_memrealtime(); }
__device__ __forceinline__ unsigned f2bf(float f) { unsigned u = __builtin_bit_cast(unsigned, f); return (u + 0x7fffu + ((u >> 16) & 1u)) >> 16; }
__device__ __forceinline__ unsigned pk2(float lo, float hi) { return f2bf(lo) | (f2bf(hi) << 16); }

#define XB_TMO      128
#define XB_XCNT(j)  (256  + 64 * (j))
#define XB_XSUB(j)  (1280 + 64 * (j))
#define XB_XGEN(j)  (2304 + 64 * (j))
#define XB_TOP      3328
#define XB_TOPGEN   3392
#define XCD_BAR_WORDS 3456
#define XB_SPIN_CAP (1u << 18)

__device__ __forceinline__ unsigned xb_ld(unsigned* p)              { return __hip_atomic_load(p, __ATOMIC_RELAXED, __HIP_MEMORY_SCOPE_AGENT); }
__device__ __forceinline__ unsigned xb_add(unsigned* p, unsigned v) { return __hip_atomic_fetch_add(p, v, __ATOMIC_RELAXED, __HIP_MEMORY_SCOPE_AGENT); }
__device__ __forceinline__ unsigned xb_xcc_id() { return (unsigned)__builtin_amdgcn_s_getreg((3 << 11) | 20) & 0xFu; }
#define XB_SPIN(cond, bar) do { unsigned _sp = 0; while (cond) { __builtin_amdgcn_s_sleep(1); \
    if ((++_sp & 255u) == 0u) { if (xb_ld(&(bar)[XB_TMO])) break; if (_sp > XB_SPIN_CAP) { atomicAdd(&(bar)[XB_TMO], 1u); break; } } } } while (0)

struct XcdBarrier {
    unsigned* bar; unsigned x;
    volatile LAS unsigned* st;
};

__device__ __forceinline__ XcdBarrier xcd_barrier_post(unsigned* bar, volatile LAS unsigned* st, const bool t0) {
    XcdBarrier b; b.bar = bar; b.x = xb_xcc_id(); b.st = st;
    if (t0) (void)xb_add(&bar[XB_XCNT(b.x)], 1u);
    return b;
}
__device__ __forceinline__ void xcd_barrier_complete(unsigned* bar, unsigned x, unsigned& nloc, unsigned& nx) {
    const unsigned G = gridDim.x * gridDim.y * gridDim.z;
    unsigned sum, cnt, mine, sp = 0u;
    for (;;) {
        sum = 0u; cnt = 0u; mine = 0u;
#pragma unroll
        for (unsigned j = 0; j < 16; ++j) { const unsigned c = xb_ld(&bar[XB_XCNT(j)]); sum += c; cnt += (c > 0u) ? 1u : 0u; mine = (j == x) ? c : mine; }
        if (sum == G) break;
        __builtin_amdgcn_s_sleep(1);
        if ((++sp & 255u) == 0u) { if (xb_ld(&bar[XB_TMO])) break; if (sp > XB_SPIN_CAP) { atomicAdd(&bar[XB_TMO], 1u); break; } }
    }
    nloc = mine > 0u ? mine : 1u; nx = cnt > 0u ? cnt : 1u;
}

__device__ __forceinline__ void xcd_barrier(const XcdBarrier& b, const bool t0) {
    asm volatile("s_waitcnt vmcnt(0)" ::: "memory");
    __syncthreads();
    if (t0) {
        unsigned* bar = b.bar;
        __builtin_amdgcn_s_waitcnt(0);
        unsigned nloc = b.st[0], nx = b.st[1];
        if (nloc == 0u) { xcd_barrier_complete(bar, b.x, nloc, nx); b.st[0] = nloc; b.st[1] = nx; }
        const unsigned old = xb_add(&bar[XB_XSUB(b.x)], 1u);
        const unsigned gen = old / nloc;
        if (old + 1u == (gen + 1u) * nloc) {
            __builtin_amdgcn_fence(__ATOMIC_RELEASE, "agent");
            asm volatile("s_waitcnt vmcnt(0)" ::: "memory");
            const unsigned og = xb_add(&bar[XB_TOP], 1u);
            const unsigned tg = og / nx;
            if (og + 1u == (tg + 1u) * nx) xb_add(&bar[XB_TOPGEN], 1u);
            else XB_SPIN(xb_ld(&bar[XB_TOPGEN]) == tg, bar);
            __builtin_amdgcn_fence(__ATOMIC_ACQUIRE, "agent");
            xb_add(&bar[XB_XGEN(b.x)], 1u);
            asm volatile("s_waitcnt vmcnt(0)" ::: "memory");
        } else {
            XB_SPIN(xb_ld(&bar[XB_XGEN(b.x)]) == gen, bar);
            __builtin_amdgcn_fence(__ATOMIC_ACQUIRE, "agent");
            asm volatile("s_waitcnt vmcnt(0)" ::: "memory");
        }
    }
    __syncthreads();
}


typedef float f32x16 __attribute__((ext_vector_type(16)));
typedef float f32x2 __attribute__((ext_vector_type(2)));
typedef unsigned u32x2 __attribute__((ext_vector_type(2)));
typedef __bf16 bf16x2_t __attribute__((ext_vector_type(2)));

constexpr int DM = 1024, NCTX = 4096, NLAT = 8192, MT = 12288, DEPTH = 4;
constexpr int NINP = 2048, NIN = 1952, DFF = 2816, NFF = 5632, NMOD = 6144;
constexpr float EPS = 1e-6f;
constexpr float LOG2E = 1.4426950408889634f;
constexpr float QS_NA = 0.125f * LOG2E;
constexpr float QS_MLA = 0.10206207261596575f * LOG2E;
constexpr float NEG_BIG = -1e30f;

constexpr size_t OUT_X = 0;
constexpr size_t OUT_NK = 12582912, OUT_NV = 16777216, OUT_CKV = 20971520, OUT_KR = 25165824, OUT_END = 25690112;

constexpr size_t KiB = 1024, MiB = 1u << 20;
constexpr size_t WS_CTL = 0, CTL_ZERO_BYTES = 1 * MiB;
constexpr size_t WS_ROPE = 1 * MiB;
constexpr size_t WS_MODS = WS_ROPE + 4 * KiB;
constexpr size_t WS_B1 = WS_MODS + 491520;
constexpr size_t WS_B2 = WS_B1 + 163840;
constexpr size_t WS_RSV = WS_B2 + 450560;
constexpr size_t WS_SSQX = WS_RSV + 49152;
constexpr size_t WS_SSQ1 = WS_SSQX + 786432;
constexpr size_t WS_WSGU = WS_SSQ1 + 786432;
static_assert(WS_WSGU + 524288 <= 8 * MiB, "ws map");
constexpr size_t WS_WIN = 8 * MiB;
constexpr size_t WS_WUQ = 24 * MiB;
constexpr size_t WS_WUKV = 27 * MiB;
constexpr size_t WS_WOUT = 29 * MiB;
constexpr size_t WS_WF1 = 37 * MiB;
constexpr size_t WS_WF2 = 81 * MiB;
constexpr size_t WS_KCNA = 103 * MiB;
constexpr size_t WS_VTCNA = 105 * MiB;
constexpr size_t WS_CKVC = 107 * MiB;
constexpr size_t WS_KRC = 109 * MiB;
constexpr size_t WS_KCMLA = 110 * MiB;
constexpr size_t WS_VTCMLA = 114 * MiB;
constexpr size_t WS_XA = 118 * MiB;
constexpr size_t WS_T = 142 * MiB;
constexpr size_t WS_QNA = WS_T, WS_KNA = WS_T + 6 * MiB, WS_VTNA = WS_T + 12 * MiB, WS_CQ = WS_T + 18 * MiB, WS_CKV = WS_T + 27 * MiB, WS_KR = WS_T + 33 * MiB,
                 WS_U = WS_T + 34 * MiB, WS_VTSGU = WS_T + 40 * MiB, WS_QMLA = WS_T + 46 * MiB, WS_KMLA = WS_T + 64 * MiB, WS_VTMLA = WS_T + 76 * MiB, WS_MIX = WS_T + 88 * MiB;
constexpr size_t WS_AFF = WS_T, WS_ACT = WS_T + 132 * MiB;
constexpr size_t WS_END = WS_T + 198 * MiB;
constexpr int CW_BAR = 4096;

constexpr int RING_BYTES = 131072;
constexpr int LDS_MISC = RING_BYTES;
constexpr int LDS_RPB = RING_BYTES + 256;
constexpr int LDS_BYTES = RING_BYTES + 16384;
constexpr int NWAVES = 8, NTHR = 512;

struct Args {
    const float* in[27];
    float* out; unsigned char* ws;
    int nphase_lo, nphase_hi;
};

__device__ __forceinline__ unsigned cvtpk(float lo, float hi) { f32x2 v = {lo, hi}; bf16x2_t b = __builtin_convertvector(v, bf16x2_t); return __builtin_bit_cast(unsigned, b); }
__device__ __forceinline__ float bf2f(unsigned short b) { return __uint_as_float((unsigned)b << 16); }
__device__ __forceinline__ float bflo(unsigned w) { return __uint_as_float(w << 16); }
__device__ __forceinline__ float bfhi(unsigned w) { return __uint_as_float(w & 0xffff0000u); }
__device__ __forceinline__ float fast_exp2(float x) { return __builtin_amdgcn_exp2f(x); }
__device__ __forceinline__ float fast_rcp(float x) { return __builtin_amdgcn_rcpf(x); }
__device__ __forceinline__ float silu_f(float x) { return x * fast_rcp(1.0f + fast_exp2(-x * LOG2E)); }
__device__ __forceinline__ float gelu_tanh_f(float x) {
    const float u = 0.7978845608028654f * (x + 0.044715f * x * x * x);
    return x * fast_rcp(1.0f + fast_exp2(-2.0f * LOG2E * u));
}
__device__ __forceinline__ float xsum32(float v) { auto r = __builtin_amdgcn_permlane32_swap(__float_as_uint(v), __float_as_uint(v), false, false); return __uint_as_float(r[0]) + __uint_as_float(r[1]); }
__device__ __forceinline__ float xmax32(float v) { auto r = __builtin_amdgcn_permlane32_swap(__float_as_uint(v), __float_as_uint(v), false, false); return fmaxf(__uint_as_float(r[0]), __uint_as_float(r[1])); }
__device__ __forceinline__ float xsum16(float v) { auto r = __builtin_amdgcn_permlane16_swap(__float_as_uint(v), __float_as_uint(v), false, false); return __uint_as_float(r[0]) + __uint_as_float(r[1]); }
template <int CTRL> __device__ __forceinline__ float dpp_f(float v) { return __uint_as_float((unsigned)__builtin_amdgcn_update_dpp(0, (int)__float_as_uint(v), CTRL, 0xf, 0xf, true)); }
__device__ __forceinline__ float wave_sum(float v) {
    v += dpp_f<0xB1>(v);
    v += dpp_f<0x4E>(v);
    v += dpp_f<0x124>(v);
    v += dpp_f<0x128>(v);
    v = xsum16(v); v = xsum32(v);
    return v;
}
__device__ __forceinline__ int modrow(int pm) { return pm < 16 ? 0 : 1 + ((pm - 16) >> 3); }


__device__ __forceinline__ v4u pack8(const f32x4& a, const f32x4& b) { v4u w; w.x = cvtpk(a.x, a.y); w.y = cvtpk(a.z, a.w); w.z = cvtpk(b.x, b.y); w.w = cvtpk(b.z, b.w); return w; }
__device__ __forceinline__ u32x2 pack4(const f32x4& a) { u32x2 w; w.x = cvtpk(a.x, a.y); w.y = cvtpk(a.z, a.w); return w; }
__device__ __forceinline__ float sum4(const f32x4& a) { return (a.x + a.y) + (a.z + a.w); }
__device__ __forceinline__ float sq4(const f32x4& a) { return (a.x * a.x + a.y * a.y) + (a.z * a.z + a.w * a.w); }
__device__ __forceinline__ float sum16f(const float* p) { const f32x4* q = (const f32x4*)p; return (sum4(q[0]) + sum4(q[1])) + (sum4(q[2]) + sum4(q[3])); }
__device__ __forceinline__ void st_bf16(bf16* p, float v) { *p = (bf16)(cvtpk(v, 0.f) & 0xffffu); }

struct EpiIn {
    static constexpr bool PERM = true, AFTER_DRAIN = false;
    int l; unsigned char* ws; float* out;
    const float* g_ckv; const float* g_sgu; const float* g_cq;

    template <int T> __device__ __forceinline__ void tile(const f32x4 (&acc)[2][2][4][2], const pg8::Unit& u, int wr, int wc, int fr, int fq) const {
        const int pm = u.pm, r = modrow(pm); const bool ctx = pm < 16;
        const int ct = wc * 32 + 8 * fq;
        const float* ssqx = (const float*)(ws + WS_SSQX); const float* bias = (const float*)(ws + WS_B1) + (size_t)l * 5 * NINP; const float* rope = (const float*)(ws + WS_ROPE);
        float* ssq1 = (float*)(ws + WS_SSQ1);
        bf16* QNA = (bf16*)(ws + WS_QNA); bf16* KNA = (bf16*)(ws + WS_KNA); bf16* VTNA = (bf16*)(ws + WS_VTNA); bf16* CKV = (bf16*)(ws + WS_CKV); bf16* VTSGU = (bf16*)(ws + WS_VTSGU);
        bf16* U = (bf16*)(ws + WS_U); bf16* CQ = (bf16*)(ws + WS_CQ); bf16* KR = (bf16*)(ws + WS_KR);
#pragma unroll
        for (int ai = 0; ai < 2; ++ai)
#pragma unroll
            for (int m = 0; m < 4; ++m) {
                const int row_t = ai * 128 + wr * 64 + m * 16 + fr; const unsigned row = (unsigned)pm * 256u + (unsigned)row_t;
                asm volatile("" ::: "memory"); __builtin_amdgcn_sched_barrier(0);
                f32x4 bv[2][2], gv[2][2];
#pragma unroll
                for (int bj = 0; bj < 2; ++bj)
#pragma unroll
                    for (int n = 0; n < 2; ++n) {
                        bv[bj][n] = *(const f32x4*)(bias + (unsigned)(r * 2048 + T * 256 + bj * 128 + ct + 4 * n));
                        gv[bj][n] = (f32x4){1.f, 1.f, 1.f, 1.f};
                        if (T == 3) gv[bj][n] = *(const f32x4*)(g_ckv + (unsigned)(bj * 128 + ct + 4 * n));
                        if (T == 4) gv[bj][n] = *(const f32x4*)(g_sgu + (unsigned)(bj * 128 + ct + 4 * n));
                        if (T == 6) gv[bj][n] = *(const f32x4*)(g_cq + (unsigned)(bj * 128 + ct + 4 * n));
                        if (T == 7 && bj == 0) gv[bj][n] = *(const f32x4*)(g_cq + (unsigned)(256 + ct + 4 * n));
                    }
                const float rstd = rsqrtf(sum16f(ssqx + row * 16u) * (1.0f / 1024.0f) + EPS);
                f32x4 z[2][2];
#pragma unroll
                for (int bj = 0; bj < 2; ++bj)
#pragma unroll
                    for (int n = 0; n < 2; ++n) z[bj][n] = acc[ai][bj][m][n] * rstd + bv[bj][n];
                if (T == 0) {
#pragma unroll
                    for (int bj = 0; bj < 2; ++bj) *(v4u*)(QNA + (row * 256u + (unsigned)(bj * 128 + ct))) = pack8(z[bj][0] * QS_NA, z[bj][1] * QS_NA);
                } else if (T == 1) {
#pragma unroll
                    for (int bj = 0; bj < 2; ++bj) {
                        *(v4u*)(KNA + (row * 256u + (unsigned)(bj * 128 + ct))) = pack8(z[bj][0], z[bj][1]);
                        if (ctx) { float* o = out + OUT_NK + (((unsigned)(pm * 4 + l) * 256u + (unsigned)row_t) * 256u + (unsigned)(bj * 128 + ct)); *(f32x4*)o = z[bj][0]; *(f32x4*)(o + 4) = z[bj][1]; }
                    }
                } else if (T == 2) {
#pragma unroll
                    for (int bj = 0; bj < 2; ++bj) {
#pragma unroll
                        for (int n = 0; n < 2; ++n)
#pragma unroll
                            for (int j = 0; j < 4; ++j) st_bf16(VTNA + ((unsigned)(bj * 128 + ct + 4 * n + j) * (unsigned)MT + row), z[bj][n][j]);
                        if (ctx) { float* o = out + OUT_NV + (((unsigned)(pm * 4 + l) * 256u + (unsigned)row_t) * 256u + (unsigned)(bj * 128 + ct)); *(f32x4*)o = z[bj][0]; *(f32x4*)(o + 4) = z[bj][1]; }
                    }
                } else if (T == 3) {
                    float ss = (sq4(z[0][0]) + sq4(z[0][1])) + (sq4(z[1][0]) + sq4(z[1][1]));
                    ss = xsum16(ss); ss = xsum32(ss);
                    if (fq == 0) ssq1[row * 16u + 0 + wc] = ss;
#pragma unroll
                    for (int bj = 0; bj < 2; ++bj) {
                        const f32x4 v0 = z[bj][0] * gv[bj][0], v1 = z[bj][1] * gv[bj][1];
                        *(v4u*)(CKV + (row * 256u + (unsigned)(bj * 128 + ct))) = pack8(v0, v1);
                        if (ctx) { float* o = out + OUT_CKV + (((unsigned)(pm * 4 + l) * 256u + (unsigned)row_t) * 256u + (unsigned)(bj * 128 + ct)); *(f32x4*)o = v0; *(f32x4*)(o + 4) = v1; }
                    }
                } else if (T == 4) {
#pragma unroll
                    for (int bj = 0; bj < 2; ++bj)
#pragma unroll
                        for (int n = 0; n < 2; ++n)
#pragma unroll
                            for (int j = 0; j < 4; ++j) z[bj][n][j] = gelu_tanh_f(z[bj][n][j]);
                    float ss = (sq4(z[0][0]) + sq4(z[0][1])) + (sq4(z[1][0]) + sq4(z[1][1]));
                    ss = xsum16(ss); ss = xsum32(ss);
                    if (fq == 0) ssq1[row * 16u + 4 + wc] = ss;
#pragma unroll
                    for (int bj = 0; bj < 2; ++bj)
#pragma unroll
                        for (int n = 0; n < 2; ++n)
#pragma unroll
                            for (int j = 0; j < 4; ++j) st_bf16(VTSGU + ((unsigned)(bj * 128 + ct + 4 * n + j) * (unsigned)MT + row), z[bj][n][j] * gv[bj][n][j]);
                } else if (T == 5) {
#pragma unroll
                    for (int bj = 0; bj < 2; ++bj) {
#pragma unroll
                        for (int n = 0; n < 2; ++n)
#pragma unroll
                            for (int j = 0; j < 4; ++j) z[bj][n][j] = gelu_tanh_f(z[bj][n][j]);
                        *(v4u*)(U + (row * 256u + (unsigned)(bj * 128 + ct))) = pack8(z[bj][0], z[bj][1]);
                    }
                } else if (T == 6) {
                    float ss = (sq4(z[0][0]) + sq4(z[0][1])) + (sq4(z[1][0]) + sq4(z[1][1]));
                    ss = xsum16(ss); ss = xsum32(ss);
                    if (fq == 0) ssq1[row * 16u + 8 + wc] = ss;
#pragma unroll
                    for (int bj = 0; bj < 2; ++bj) *(v4u*)(CQ + (row * 384u + (unsigned)(bj * 128 + ct))) = pack8(z[bj][0] * gv[bj][0], z[bj][1] * gv[bj][1]);
                } else {
                    float ss = sq4(z[0][0]) + sq4(z[0][1]);
                    ss = xsum16(ss); ss = xsum32(ss);
                    if (fq == 0) ssq1[row * 16u + 12 + wc] = ss;
                    *(v4u*)(CQ + (row * 384u + (unsigned)(256 + ct))) = pack8(z[0][0] * gv[0][0], z[0][1] * gv[0][1]);
                    if (wc == 0) {
                        const int part = fq >> 1, i0 = 4 * (fq & 1);
                        f32x4 x1 = z[1][0], x2 = z[1][1];
                        if (ctx) {
                            float* o = out + OUT_KR + (((unsigned)(pm * 4 + l) * 256u + (unsigned)row_t) * 32u + (unsigned)(part * 16 + i0));
                            *(f32x4*)o = x1; *(f32x4*)(o + 8) = x2;
                        } else {
                            const int t = ((pm - 16) & 7) * 256 + row_t; const int pos = part ? (t & 63) : (t >> 6);
                            const f32x4 cs0 = *(const f32x4*)(rope + (pos * 8 + i0) * 2), cs1 = *(const f32x4*)(rope + (pos * 8 + i0) * 2 + 4);
                            const f32x4 c = {cs0.x, cs0.z, cs1.x, cs1.z}, s = {cs0.y, cs0.w, cs1.y, cs1.w};
                            const f32x4 o1 = x1 * c - x2 * s, o2 = x1 * s + x2 * c; x1 = o1; x2 = o2;
                        }
                        *(u32x2*)(KR + (row * 32u + (unsigned)(part * 16 + i0))) = pack4(x1); *(u32x2*)(KR + (row * 32u + (unsigned)(part * 16 + 8 + i0))) = pack4(x2);
                    }
                }
            }
    }
    __device__ __forceinline__ void operator()(const f32x4 (&acc)[2][2][4][2], const pg8::Unit& u, int wr, int wc, int fr, int fq) const {
#ifndef TMASK
#define TMASK 0xFF
#endif
        switch (u.pn) {
            case 0: if (TMASK & 1) tile<0>(acc, u, wr, wc, fr, fq); break;
            case 1: if (TMASK & 2) tile<1>(acc, u, wr, wc, fr, fq); break;
            case 2: if (TMASK & 4) tile<2>(acc, u, wr, wc, fr, fq); break;
            case 3: if (TMASK & 8) tile<3>(acc, u, wr, wc, fr, fq); break;
            case 4: if (TMASK & 16) tile<4>(acc, u, wr, wc, fr, fq); break;
            case 5: if (TMASK & 32) tile<5>(acc, u, wr, wc, fr, fq); break;
            case 6: if (TMASK & 64) tile<6>(acc, u, wr, wc, fr, fq); break;
            default: if (TMASK & 128) tile<7>(acc, u, wr, wc, fr, fq); break;
        }
    }
};

struct EpiQ {
    static constexpr bool PERM = true, AFTER_DRAIN = false;
    unsigned char* ws;
    __device__ __forceinline__ void operator()(const f32x4 (&acc)[2][2][4][2], const pg8::Unit& u, int wr, int wc, int fr, int fq) const {
        const int pm = u.pm, pn = u.pn; const bool ctx = pm < 16; const int ct = wc * 32 + 8 * fq;
        const float* ssq1 = (const float*)(ws + WS_SSQ1); const float* rope = (const float*)(ws + WS_ROPE); bf16* QMLA = (bf16*)(ws + WS_QMLA);
#pragma unroll
        for (int ai = 0; ai < 2; ++ai)
#pragma unroll
            for (int m = 0; m < 4; ++m) {
                const int row_t = ai * 128 + wr * 64 + m * 16 + fr; const unsigned row = (unsigned)pm * 256u + (unsigned)row_t;
                asm volatile("" ::: "memory"); __builtin_amdgcn_sched_barrier(0);
                const f32x4* sp = (const f32x4*)(ssq1 + (row * 16u + 8u));
                const float rs = rsqrtf((sum4(sp[0]) + sum4(sp[1])) * (1.0f / 384.0f) + EPS) * QS_MLA;
                if (pn < 2) {
#pragma unroll
                    for (int bj = 0; bj < 2; ++bj) { const int cc = pn * 256 + bj * 128 + ct, h = cc >> 6, d = cc & 63;
                        *(v4u*)(QMLA + (row * 768u + (unsigned)(h * 96 + d))) = pack8(acc[ai][bj][m][0] * rs, acc[ai][bj][m][1] * rs); }
                } else {
                    const int part = fq >> 1, i0 = 4 * (fq & 1);
                    f32x4 c = {1.f, 1.f, 1.f, 1.f}, s = {0.f, 0.f, 0.f, 0.f};
                    if (!ctx) { const int t = ((pm - 16) & 7) * 256 + row_t; const int pos = part ? (t & 63) : (t >> 6);
                        const f32x4 cs0 = *(const f32x4*)(rope + (pos * 8 + i0) * 2), cs1 = *(const f32x4*)(rope + (pos * 8 + i0) * 2 + 4);
                        c = (f32x4){cs0.x, cs0.z, cs1.x, cs1.z}; s = (f32x4){cs0.y, cs0.w, cs1.y, cs1.w}; }
#pragma unroll
                    for (int bj = 0; bj < 2; ++bj) { const int h = bj * 4 + wc;
                        const f32x4 x1 = acc[ai][bj][m][0] * rs, x2 = acc[ai][bj][m][1] * rs;
                        const f32x4 o1 = x1 * c - x2 * s, o2 = x1 * s + x2 * c;
                        bf16* dst = QMLA + (row * 768u + (unsigned)(h * 96 + 64 + part * 16 + i0));
                        *(u32x2*)dst = pack4(o1); *(u32x2*)(dst + 8) = pack4(o2); }
                }
            }
    }
};

struct EpiKV {
    static constexpr bool PERM = true, AFTER_DRAIN = false;
    const float* ssq1; bf16* K; bf16* VT; int vtpitch;
    __device__ __forceinline__ void operator()(const f32x4 (&acc)[2][2][4][2], const pg8::Unit& u, int wr, int wc, int fr, int fq) const {
        const int pm = u.pm, pn = u.pn; const int ct = wc * 32 + 8 * fq;
#pragma unroll
        for (int ai = 0; ai < 2; ++ai)
#pragma unroll
            for (int m = 0; m < 4; ++m) {
                const unsigned row = (unsigned)(pm * 256 + ai * 128 + wr * 64 + m * 16 + fr);
                asm volatile("" ::: "memory"); __builtin_amdgcn_sched_barrier(0);
                float rs = 1.0f;
                if (ssq1) rs = rsqrtf(sum4(*(const f32x4*)(ssq1 + row * 16u)) * (1.0f / 256.0f) + EPS);
                if (pn < 2) {
#pragma unroll
                    for (int bj = 0; bj < 2; ++bj) *(v4u*)(K + (row * 512u + (unsigned)(pn * 256 + bj * 128 + ct))) = pack8(acc[ai][bj][m][0] * rs, acc[ai][bj][m][1] * rs);
                } else {
#pragma unroll
                    for (int bj = 0; bj < 2; ++bj)
#pragma unroll
                        for (int n = 0; n < 2; ++n)
#pragma unroll
                            for (int j = 0; j < 4; ++j) st_bf16(VT + ((unsigned)((pn - 2) * 256 + bj * 128 + ct + 4 * n + j) * (unsigned)vtpitch + row), acc[ai][bj][m][n][j] * rs);
                }
            }
    }
};

struct EpiRes {
    static constexpr bool PERM = true, AFTER_DRAIN = false;
    const float* base_ctx; const float* base_lat; float* xout; bf16* XA;
    const float* gate; const float* gnext; const float* scnext; float* ssqx;
    __device__ __forceinline__ void operator()(const f32x4 (&acc)[2][2][4][2], const pg8::Unit& u, int wr, int wc, int fr, int fq) const {
        const int pm = u.pm, pn = u.pn, r = modrow(pm); const int ct = pn * 256 + wc * 32 + 8 * fq;
        f32x4 gt[2][2], gm[2][2];
#pragma unroll
        for (int bj = 0; bj < 2; ++bj)
#pragma unroll
            for (int n = 0; n < 2; ++n) { const int col = ct + bj * 128 + 4 * n;
                gt[bj][n] = *(const f32x4*)(gate + r * NMOD + col);
                gm[bj][n] = (f32x4){0.f, 0.f, 0.f, 0.f};
                if (XA) gm[bj][n] = *(const f32x4*)(gnext + col) * (*(const f32x4*)(scnext + r * NMOD + col) + 1.0f); }
#pragma unroll
        for (int ai = 0; ai < 2; ++ai)
#pragma unroll
            for (int m = 0; m < 4; ++m) {
                const unsigned row = (unsigned)(pm * 256 + ai * 128 + wr * 64 + m * 16 + fr);
                asm volatile("" ::: "memory"); __builtin_amdgcn_sched_barrier(0);
                const float* bp = (pm < 16) ? base_ctx + row * (unsigned)DM : base_lat + (row - (unsigned)NCTX) * (unsigned)DM;
                float ss = 0.f;
#pragma unroll
                for (int bj = 0; bj < 2; ++bj) {
                    const int col = ct + bj * 128;
                    const f32x4 x0 = *(const f32x4*)(bp + col) + gt[bj][0] * acc[ai][bj][m][0];
                    const f32x4 x1 = *(const f32x4*)(bp + col + 4) + gt[bj][1] * acc[ai][bj][m][1];
                    *(f32x4*)(xout + (row * (unsigned)DM + (unsigned)col)) = x0; *(f32x4*)(xout + (row * (unsigned)DM + (unsigned)col + 4u)) = x1;
                    ss += sq4(x0) + sq4(x1);
                    if (XA) *(v4u*)(XA + (row * (unsigned)DM + (unsigned)col)) = pack8(x0 * gm[bj][0], x1 * gm[bj][1]);
                }
                ss = xsum16(ss); ss = xsum32(ss);
                if (fq == 0) ssqx[row * 16u + (unsigned)(pn * 4 + wc)] = ss;
            }
    }
};

struct EpiFF1 {
    static constexpr bool PERM = true, AFTER_DRAIN = false;
    const float* ssqx; const float* bias; bf16* AFF;
    __device__ __forceinline__ void operator()(const f32x4 (&acc)[2][2][4][2], const pg8::Unit& u, int wr, int wc, int fr, int fq) const {
        const int pm = u.pm, pn = u.pn, r = modrow(pm); const int ct = pn * 256 + wc * 32 + 8 * fq;
        f32x4 bv[2][2];
#pragma unroll
        for (int bj = 0; bj < 2; ++bj)
#pragma unroll
            for (int n = 0; n < 2; ++n) bv[bj][n] = *(const f32x4*)(bias + r * NFF + ct + bj * 128 + 4 * n);
#pragma unroll
        for (int ai = 0; ai < 2; ++ai)
#pragma unroll
            for (int m = 0; m < 4; ++m) {
                const unsigned row = (unsigned)(pm * 256 + ai * 128 + wr * 64 + m * 16 + fr);
                asm volatile("" ::: "memory"); __builtin_amdgcn_sched_barrier(0);
                const float rstd = rsqrtf(sum16f(ssqx + row * 16u) * (1.0f / 1024.0f) + EPS);
#pragma unroll
                for (int bj = 0; bj < 2; ++bj)
                    *(v4u*)(AFF + (row * (unsigned)NFF + (unsigned)(ct + bj * 128))) = pack8(acc[ai][bj][m][0] * rstd + bv[bj][0], acc[ai][bj][m][1] * rstd + bv[bj][1]);
            }
    }
};


__device__ __forceinline__ f32x16 mfma32(bf16x8 a, bf16x8 b, f32x16 c) { return __builtin_amdgcn_mfma_f32_32x32x16_bf16(a, b, c, 0, 0, 0); }
__device__ __forceinline__ bf16x8 ld8(const bf16* p) { return *(const bf16x8*)p; }

struct NoMod { __device__ __forceinline__ void operator()(f32x16&) const {} };
struct NaMod {
    const LAS float* rpb; int c, cs, kc0;
    __device__ __forceinline__ void operator()(f32x16& S) const {
#pragma unroll
        for (int s = 0; s < 2; ++s)
#pragma unroll
            for (int j = 0; j < 8; ++j) { const int kc = kc0 + 16 * s + j; const bool ok = (unsigned)(kc - cs) < 16u;
                int co = kc - c; co = co < -15 ? -15 : (co > 15 ? 15 : co);
                const float b = rpb[co + 15];
                S[8 * s + j] = ok ? S[8 * s + j] + b : NEG_BIG; }
    }
};

template <int DK, class Mod>
__device__ __forceinline__ void attn_tile(const bf16x8 (&q)[DK / 16], f32x16 (&o)[2], float& m, float& l, const bf16* Krow, const bf16* KRrow, const bf16* VTp, size_t vtpitch, const Mod& mod) {
    bf16x8 kf[DK / 16];
#pragma unroll
    for (int d0 = 0; d0 < 4; ++d0) kf[d0] = ld8(Krow + 16 * d0);
    if constexpr (DK == 96) { kf[4] = ld8(KRrow); kf[5] = ld8(KRrow + 16); }
    bf16x8 vf[2][2];
#pragma unroll
    for (int blk = 0; blk < 2; ++blk)
#pragma unroll
        for (int s = 0; s < 2; ++s) vf[blk][s] = ld8(VTp + (size_t)(32 * blk) * vtpitch + 16 * s);
    f32x16 S;
#pragma unroll
    for (int i = 0; i < 16; ++i) S[i] = 0.f;
#pragma unroll
    for (int d0 = 0; d0 < DK / 16; ++d0) S = mfma32(kf[d0], q[d0], S);
    mod(S);
    float mx = S[0];
#pragma unroll
    for (int i = 1; i < 16; ++i) mx = fmaxf(mx, S[i]);
    mx = xmax32(mx);
    const float mn = fmaxf(m, mx); const float alpha = fast_exp2(m - mn); m = mn;
    float ps = 0.f;
#pragma unroll
    for (int i = 0; i < 16; ++i) { S[i] = fast_exp2(S[i] - mn); ps += S[i]; }
    l = l * alpha + ps;
#pragma unroll
    for (int i = 0; i < 16; ++i) { o[0][i] *= alpha; o[1][i] *= alpha; }
    v4u p0, p1;
    p0.x = cvtpk(S[0], S[1]); p0.y = cvtpk(S[2], S[3]); p0.z = cvtpk(S[4], S[5]); p0.w = cvtpk(S[6], S[7]);
    p1.x = cvtpk(S[8], S[9]); p1.y = cvtpk(S[10], S[11]); p1.z = cvtpk(S[12], S[13]); p1.w = cvtpk(S[14], S[15]);
    const bf16x8 pb0 = __builtin_bit_cast(bf16x8, p0), pb1 = __builtin_bit_cast(bf16x8, p1);
    o[0] = mfma32(vf[0][0], pb0, o[0]); o[0] = mfma32(vf[0][1], pb1, o[0]);
    o[1] = mfma32(vf[1][0], pb0, o[1]); o[1] = mfma32(vf[1][1], pb1, o[1]);
}
__device__ __forceinline__ void attn_store(const f32x16 (&o)[2], float l, bf16* dst, int hi) {
    const float lt = xsum32(l); const float inv = 1.0f / lt;
#pragma unroll
    for (int blk = 0; blk < 2; ++blk)
#pragma unroll
        for (int g = 0; g < 4; ++g) { const f32x4 v = {o[blk][4 * g] * inv, o[blk][4 * g + 1] * inv, o[blk][4 * g + 2] * inv, o[blk][4 * g + 3] * inv};
            *(u32x2*)(dst + 32 * blk + 8 * g + 4 * hi) = pack4(v); }
}

struct P3Ptrs {
    unsigned char* ws; int l; const float* b_sgu;
    __device__ __forceinline__ const bf16* p(size_t off) const { return (const bf16*)(ws + off); }
};
#define P3_QNA P.p(WS_QNA)
#define P3_KNA P.p(WS_KNA)
#define P3_VTNA P.p(WS_VTNA)
#define P3_KCNA (P.p(WS_KCNA) + (size_t)P.l * 1024 * 256)
#define P3_VTCNA (P.p(WS_VTCNA) + (size_t)P.l * 256 * 1024)
#define P3_QMLA P.p(WS_QMLA)
#define P3_KMLA P.p(WS_KMLA)
#define P3_KR P.p(WS_KR)
#define P3_VTMLA P.p(WS_VTMLA)
#define P3_KCMLA (P.p(WS_KCMLA) + (size_t)P.l * 1024 * 512)
#define P3_KRC (P.p(WS_KRC) + (size_t)P.l * 1024 * 32)
#define P3_VTCMLA (P.p(WS_VTCMLA) + (size_t)P.l * 512 * 1024)
#define P3_U P.p(WS_U)
#define P3_VTSGU P.p(WS_VTSGU)
#define P3_WSGU (P.p(WS_WSGU) + (size_t)P.l * 4 * 128 * 128)
#define P3_RSV ((const float*)(P.ws + WS_RSV))
#define P3_MIX ((bf16*)(P.ws + WS_MIX))

__device__ __forceinline__ void unit_mla_lat(const P3Ptrs& P, int u, int lane) {
    const int r32 = lane & 31, hi = lane >> 5, kap = (r32 & ~12) | ((r32 & 8) >> 1) | ((r32 & 4) << 1);
    const int qb = u & 63, h = (u >> 6) & 7, b = u >> 9;
    const size_t mq = (size_t)NCTX + (size_t)b * 2048 + 32 * qb + r32;
    bf16x8 q[6];
#pragma unroll
    for (int d0 = 0; d0 < 6; ++d0) q[d0] = ld8(P3_QMLA + mq * 768 + h * 96 + 16 * d0 + 8 * hi);
    f32x16 o[2];
#pragma unroll
    for (int i = 0; i < 16; ++i) { o[0][i] = 0.f; o[1][i] = 0.f; }
    float m = NEG_BIG, l = 0.f;
    {
        const bf16* Kb = P3_KCMLA + ((size_t)(b * 256 + kap)) * 512 + h * 64 + 8 * hi;
        const bf16* Rb = P3_KRC + ((size_t)(b * 256 + kap)) * 32 + 8 * hi;
        const bf16* Vb = P3_VTCMLA + (size_t)(h * 64 + r32) * 1024 + b * 256 + 8 * hi;
        for (int t = 0; t < 8; ++t) attn_tile<96>(q, o, m, l, Kb + (size_t)t * 32 * 512, Rb + (size_t)t * 32 * 32, Vb + t * 32, (size_t)1024, NoMod());
    }
    {
        const size_t mk = (size_t)NCTX + (size_t)b * 2048;
        const bf16* Kb = P3_KMLA + (mk + kap) * 512 + h * 64 + 8 * hi;
        const bf16* Rb = P3_KR + (mk + kap) * 32 + 8 * hi;
        const bf16* Vb = P3_VTMLA + (size_t)(h * 64 + r32) * MT + mk + 8 * hi;
        for (int t = 0; t < 64; ++t) attn_tile<96>(q, o, m, l, Kb + (size_t)t * 32 * 512, Rb + (size_t)t * 32 * 32, Vb + t * 32, (size_t)MT, NoMod());
    }
    attn_store(o, l, P3_MIX + mq * 1024 + 256 + h * 64, hi);
}
__device__ __forceinline__ void unit_mla_ctx(const P3Ptrs& P, int u, int lane) {
    const int r32 = lane & 31, hi = lane >> 5, kap = (r32 & ~12) | ((r32 & 8) >> 1) | ((r32 & 4) << 1);
    const int qb = u & 7, h = (u >> 3) & 7, b = u >> 6;
    const size_t mq = (size_t)b * 256 + 32 * qb + r32, mk = (size_t)b * 256;
    bf16x8 q[6];
#pragma unroll
    for (int d0 = 0; d0 < 6; ++d0) q[d0] = ld8(P3_QMLA + mq * 768 + h * 96 + 16 * d0 + 8 * hi);
    f32x16 o[2];
#pragma unroll
    for (int i = 0; i < 16; ++i) { o[0][i] = 0.f; o[1][i] = 0.f; }
    float m = NEG_BIG, l = 0.f;
    const bf16* Kb = P3_KMLA + (mk + kap) * 512 + h * 64 + 8 * hi;
    const bf16* Rb = P3_KR + (mk + kap) * 32 + 8 * hi;
    const bf16* Vb = P3_VTMLA + (size_t)(h * 64 + r32) * MT + mk + 8 * hi;
    for (int t = 0; t < 8; ++t) attn_tile<96>(q, o, m, l, Kb + (size_t)t * 32 * 512, Rb + (size_t)t * 32 * 32, Vb + t * 32, (size_t)MT, NoMod());
    attn_store(o, l, P3_MIX + mq * 1024 + 256 + h * 64, hi);
}
__device__ __forceinline__ void unit_na_ctx(const P3Ptrs& P, int u, int lane) {
    const int r32 = lane & 31, hi = lane >> 5, kap = (r32 & ~12) | ((r32 & 8) >> 1) | ((r32 & 4) << 1);
    const int qb = u & 7, h = (u >> 3) & 3, b = u >> 5;
    const size_t mq = (size_t)b * 256 + 32 * qb + r32, mk = (size_t)b * 256;
    bf16x8 q[4];
#pragma unroll
    for (int d0 = 0; d0 < 4; ++d0) q[d0] = ld8(P3_QNA + mq * 256 + h * 64 + 16 * d0 + 8 * hi);
    f32x16 o[2];
#pragma unroll
    for (int i = 0; i < 16; ++i) { o[0][i] = 0.f; o[1][i] = 0.f; }
    float m = NEG_BIG, l = 0.f;
    const bf16* Kb = P3_KNA + (mk + kap) * 256 + h * 64 + 8 * hi;
    const bf16* Vb = P3_VTNA + (size_t)(h * 64 + r32) * MT + mk + 8 * hi;
    for (int t = 0; t < 8; ++t) attn_tile<64>(q, o, m, l, Kb + (size_t)t * 32 * 256, nullptr, Vb + t * 32, (size_t)MT, NoMod());
    attn_store(o, l, P3_MIX + mq * 1024 + h * 64, hi);
}
__device__ __forceinline__ void unit_na_lat(const P3Ptrs& P, int u, int lane, const LAS float* rpb) {
    const int r32 = lane & 31, hi = lane >> 5, kap = (r32 & ~12) | ((r32 & 8) >> 1) | ((r32 & 4) << 1);
    const int qh = u & 1, gr = (u >> 1) & 31, h = (u >> 6) & 3, b = u >> 8;
    const int c = 32 * qh + r32;
    const size_t mb = (size_t)NCTX + (size_t)b * 2048, mq = mb + gr * 64 + c;
    bf16x8 q[4];
#pragma unroll
    for (int d0 = 0; d0 < 4; ++d0) q[d0] = ld8(P3_QNA + mq * 256 + h * 64 + 16 * d0 + 8 * hi);
    f32x16 o[2];
#pragma unroll
    for (int i = 0; i < 16; ++i) { o[0][i] = 0.f; o[1][i] = 0.f; }
    float m = NEG_BIG, l = 0.f;
    {
        const bf16* Kb = P3_KCNA + ((size_t)(b * 256 + kap)) * 256 + h * 64 + 8 * hi;
        const bf16* Vb = P3_VTCNA + (size_t)(h * 64 + r32) * 1024 + b * 256 + 8 * hi;
        for (int t = 0; t < 8; ++t) attn_tile<64>(q, o, m, l, Kb + (size_t)t * 32 * 256, nullptr, Vb + t * 32, (size_t)1024, NoMod());
    }
    int R0 = gr - 4; R0 = R0 < 0 ? 0 : (R0 > 24 ? 24 : R0);
    int cs = c - 8; cs = cs < 0 ? 0 : (cs > 48 ? 48 : cs);
    for (int t = 0; t < 16; ++t) {
        const int j = t >> 1, half = t & 1, kr = R0 + j;
        const size_t mk = mb + (size_t)kr * 64 + 32 * half;
        NaMod mod; mod.rpb = rpb + (h * 15 + (kr - gr + 7)) * 31; mod.c = c; mod.cs = cs; mod.kc0 = 32 * half + 8 * hi;
        attn_tile<64>(q, o, m, l, P3_KNA + (mk + kap) * 256 + h * 64 + 8 * hi, nullptr, P3_VTNA + (size_t)(h * 64 + r32) * MT + mk + 8 * hi, (size_t)MT, mod);
    }
    attn_store(o, l, P3_MIX + mq * 1024 + h * 64, hi);
}
__device__ __forceinline__ void unit_sgu(const P3Ptrs& P, int u, int lane) {
    const int r32 = lane & 31, hi = lane >> 5;
    const int pb = u & 3, g = (u >> 2) & 3, chunk = u >> 4;
    const size_t m0 = (size_t)chunk * 128;
    f32x16 a0, a1;
#pragma unroll
    for (int i = 0; i < 16; ++i) { a0[i] = 0.f; a1[i] = 0.f; }
    const bf16* Wp = P3_WSGU + ((size_t)g * 128 + 32 * pb + r32) * 128 + 8 * hi;
    const bf16* V0 = P3_VTSGU + (size_t)(g * 64 + r32) * MT + m0 + 8 * hi;
    const float* Rp = P3_RSV + m0 + 8 * hi;
#pragma unroll 2
    for (int s = 0; s < 8; ++s) {
        const v4u wr = *(const v4u*)(Wp + 16 * s);
        const f32x4 r0 = *(const f32x4*)(Rp + 16 * s), r1 = *(const f32x4*)(Rp + 16 * s + 4);
        v4u wb; wb.x = cvtpk(bflo(wr.x) * r0.x, bfhi(wr.x) * r0.y); wb.y = cvtpk(bflo(wr.y) * r0.z, bfhi(wr.y) * r0.w);
        wb.z = cvtpk(bflo(wr.z) * r1.x, bfhi(wr.z) * r1.y); wb.w = cvtpk(bflo(wr.w) * r1.z, bfhi(wr.w) * r1.w);
        const bf16x8 bfr = __builtin_bit_cast(bf16x8, wb);
        a0 = mfma32(ld8(V0 + 16 * s), bfr, a0);
        a1 = mfma32(ld8(V0 + (size_t)32 * MT + 16 * s), bfr, a1);
    }
    const float bs = P.b_sgu[g * 128 + 32 * pb + r32];
    const size_t row = m0 + 32 * pb + r32;
#pragma unroll
    for (int blk = 0; blk < 2; ++blk)
#pragma unroll
        for (int gg = 0; gg < 4; ++gg) { const int d0 = g * 64 + 32 * blk + 8 * gg + 4 * hi;
            const u32x2 uu = *(const u32x2*)(P3_U + row * 256 + d0);
            const f32x16& a = blk ? a1 : a0;
            const f32x4 v = {bflo(uu.x) * (a[4 * gg] + bs), bfhi(uu.x) * (a[4 * gg + 1] + bs), bflo(uu.y) * (a[4 * gg + 2] + bs), bfhi(uu.y) * (a[4 * gg + 3] + bs)};
            *(u32x2*)(P3_MIX + row * 1024 + 768 + d0) = pack4(v); }
}


template <class Map>
__device__ __forceinline__ void transpose_item(const float* W, int N, bf16* WT, size_t dpitch, int koff, LAS float* scr, int k0, int n0d, int lane, const Map& map) {
    const int sc = map(n0d + (lane & 31));
#pragma unroll 8
    for (int i = 0; i < 32; ++i) { const int kk = 2 * i + (lane >> 5); scr[kk * 33 + (lane & 31)] = sc >= 0 ? W[(size_t)(k0 + kk) * N + sc] : 0.f; }
    LDS_WAIT(); asm volatile("" ::: "memory");
    const int c = lane & 7;
#pragma unroll
    for (int j = 0; j < 4; ++j) { const int n = (lane >> 3) + 8 * j; const LAS float* s = scr + (8 * c) * 33 + n;
        v4u o; o.x = cvtpk(s[0 * 33], s[1 * 33]); o.y = cvtpk(s[2 * 33], s[3 * 33]); o.z = cvtpk(s[4 * 33], s[5 * 33]); o.w = cvtpk(s[6 * 33], s[7 * 33]);
        *(v4u*)(WT + (size_t)(n0d + n) * dpitch + koff + k0 + 8 * c) = o; }
    LDS_WAIT(); asm volatile("" ::: "memory");
}
struct MapId { __device__ __forceinline__ int operator()(int n) const { return n; } };
__device__ __forceinline__ int rope_src(int p) { const int fq = p >> 3, e = p & 7; return (fq >> 1) * 16 + ((e >> 2) << 3) + 4 * (fq & 1) + (e & 3); }
struct MapIn { __device__ __forceinline__ int operator()(int n) const {
    if (n < 768) return n;
    if (n < 1024) return 1152 + (n - 768);
    if (n < 1280) return 1696 + (n - 1024);
    if (n < 1536) return 1440 + (n - 1280);
    if (n < 1920) return 768 + (n - 1536);
    if (n < 1952) return 1408 + rope_src(n - 1920);
    return -1; } };
struct MapUq { __device__ __forceinline__ int operator()(int n) const {
    if (n < 512) return (n >> 6) * 96 + (n & 63);
    const int h = (n - 512) >> 5, p = (n - 512) & 31; return h * 96 + 64 + rope_src(p); } };
struct MapUkv { __device__ __forceinline__ int operator()(int n) const {
    if (n < 512) return (n >> 6) * 128 + (n & 63);
    return ((n - 512) >> 6) * 128 + 64 + (n & 63); } };

typedef __attribute__((address_space(4))) const unsigned char* kptr_t;
__device__ __forceinline__ kptr_t kargs() { kptr_t p = (kptr_t)__builtin_amdgcn_kernarg_segment_ptr(); asm volatile("" : "+s"(p)); return p; }
#define KIN(i) (*(const float* const __attribute__((address_space(4)))*)(kp + 8 * (i)))
#define KOUT() (*(float* const __attribute__((address_space(4)))*)(kp + 216))
#define KWS() (*(unsigned char* const __attribute__((address_space(4)))*)(kp + 224))
#define WSP(T, off) ((T*)(ws + (off)))

#ifndef EN_MASK
#define EN_MASK 0xFFFFF
#endif
#define EN(n) (((EN_MASK) >> (n)) & 1)
__global__ void __launch_bounds__(NTHR, 2) fwd_megakernel(Args args) {
    extern __shared__ __attribute__((aligned(16))) unsigned char lds_raw[];
    LAS unsigned char* lds = (LAS unsigned char*)lds_raw;
    const int wave0 = __builtin_amdgcn_readfirstlane((int)threadIdx.x >> 6);
    const int G0 = gridDim.x, bx0 = blockIdx.x;
#define PHASE_VARS() \
    kptr_t kp = kargs(); unsigned char* ws = KWS(); (void)ws; \
    int G = G0, bx = bx0, wave = wave0; asm volatile("" : "+s"(G), "+s"(bx), "+s"(wave)); \
    const int vcu = (G % 8 == 0) ? (bx % 8) * (G / 8) + bx / 8 : bx; \
    const int gw = vcu * NWAVES + wave, NGW = G * NWAVES, NGT = G * NTHR; \
    const int lane = pg8::pg8_lane_id_v(); const int tid = wave * 64 + lane; const int gt = vcu * NTHR + tid; \
    (void)gw; (void)NGW; (void)NGT; (void)gt; (void)tid;

    { PHASE_VARS();
      for (int i = tid; i < 64; i += NTHR) ((LAS unsigned*)(lds + LDS_MISC))[i] = 0u;
      __syncthreads();
      (void)xcd_barrier_post((unsigned*)(ws + WS_CTL) + CW_BAR, (volatile LAS unsigned*)(lds + LDS_MISC + 32), tid == 0); }
#define GRID_BAR_STR2(x) #x
#define GRID_BAR_STR(x) GRID_BAR_STR2(x)
#define GRID_BAR() do { asm volatile("; GRIDBAR line " GRID_BAR_STR(__LINE__)); kptr_t kpb = kargs(); XcdBarrier bb; bb.bar = (unsigned*)((*(unsigned char* const __attribute__((address_space(4)))*)(kpb + 224)) + WS_CTL) + CW_BAR; bb.x = xb_xcc_id(); bb.st = (volatile LAS unsigned*)(lds + LDS_MISC + 32); xcd_barrier(bb, wave0 == 0 && pg8::pg8_lane_id_v() == 0); } while (0)

    if (EN(0)) {
        PHASE_VARS();
        const float* c_lat = KIN(6); const float* c_ctx = KIN(7); const float* w_mod = KIN(8); const float* b_mod = KIN(9); float* MODS = WSP(float, WS_MODS);
        LAS float* sc = (LAS float*)lds;
        LAS float* part = (LAS float*)(lds + 20480);
        for (int i = tid; i < 5 * 1024; i += NTHR) { const int r = i >> 10, k = i & 1023; const float cv = (r == 0) ? c_ctx[k] : c_lat[(r - 1) * 1024 + k]; sc[i] = cv / (1.0f + expf(-cv)); }
        __syncthreads();
        for (int item = bx; item < DEPTH * 48; item += G) {
            const int l = item / 48, n0 = (item % 48) * 128;
            float a[5][2];
#pragma unroll
            for (int r = 0; r < 5; ++r) { a[r][0] = 0.f; a[r][1] = 0.f; }
            const float* wp = w_mod + ((size_t)l * 1024 + wave * 128) * NMOD + n0 + 2 * lane;
#pragma unroll 8
            for (int k = 0; k < 128; ++k) { const f32x2 wv = *(const f32x2*)(wp + (size_t)k * NMOD);
#pragma unroll
                for (int r = 0; r < 5; ++r) { const float s = sc[r * 1024 + wave * 128 + k]; a[r][0] += s * wv.x; a[r][1] += s * wv.y; } }
#pragma unroll
            for (int r = 0; r < 5; ++r) { part[(wave * 5 + r) * 128 + 2 * lane] = a[r][0]; part[(wave * 5 + r) * 128 + 2 * lane + 1] = a[r][1]; }
            __syncthreads();
            for (int i = tid; i < 640; i += NTHR) { const int r = i >> 7, cc = i & 127; float s = b_mod[l * NMOD + n0 + cc];
#pragma unroll
                for (int w = 0; w < 8; ++w) s += part[(w * 5 + r) * 128 + cc];
                MODS[(size_t)(l * 5 + r) * NMOD + n0 + cc] = s; }
            __syncthreads();
        }
        __syncthreads();
    }
    if (EN(1)) {
        PHASE_VARS();
        LAS float* scr = (LAS float*)(lds + wave * 16384);
        constexpr int I_IN = 16 * 64, I_UQ = 6 * 24, I_UKV = 4 * 32, I_OUT = 16 * 32, I_F1 = 16 * 176, I_F2 = 44 * 32, I_CV = 4 * 4 * 8;
        constexpr int I_LAYER = I_IN + I_UQ + I_UKV + I_OUT + I_F1 + I_F2 + I_CV;
        for (int it = gw; it < DEPTH * I_LAYER; it += NGW) {
            const int l = it / I_LAYER; int r = it % I_LAYER;
            if (r < I_IN) { transpose_item(KIN(11) + (size_t)l * 1024 * NIN, NIN, WSP(bf16, WS_WIN) + (size_t)l * NINP * 1024, 1024, 0, scr, (r / 64) * 64, (r % 64) * 32, lane, MapIn()); continue; } r -= I_IN;
            if (r < I_UQ) { transpose_item(KIN(14) + (size_t)l * 384 * 768, 768, WSP(bf16, WS_WUQ) + (size_t)l * 768 * 384, 384, 0, scr, (r / 24) * 64, (r % 24) * 32, lane, MapUq()); continue; } r -= I_UQ;
            if (r < I_UKV) { transpose_item(KIN(16) + (size_t)l * 256 * 1024, 1024, WSP(bf16, WS_WUKV) + (size_t)l * 1024 * 256, 256, 0, scr, (r / 32) * 64, (r % 32) * 32, lane, MapUkv()); continue; } r -= I_UKV;
            if (r < I_OUT) { transpose_item(KIN(20) + (size_t)l * 1024 * 1024, 1024, WSP(bf16, WS_WOUT) + (size_t)l * 1024 * 1024, 1024, 0, scr, (r / 32) * 64, (r % 32) * 32, lane, MapId()); continue; } r -= I_OUT;
            if (r < I_F1) { transpose_item(KIN(22) + (size_t)l * 1024 * NFF, NFF, WSP(bf16, WS_WF1) + (size_t)l * NFF * 1024, 1024, 0, scr, (r / 176) * 64, (r % 176) * 32, lane, MapId()); continue; } r -= I_F1;
            if (r < I_F2) { transpose_item(KIN(25) + (size_t)l * DFF * 1024, 1024, WSP(bf16, WS_WF2) + (size_t)l * 1024 * DFF, DFF, 0, scr, (r / 32) * 64, (r % 32) * 32, lane, MapId()); continue; } r -= I_F2;
            { const int b = r / 32, q = r % 32;
              transpose_item(KIN(3) + (size_t)(b * 4 + l) * 256 * 256, 256, WSP(bf16, WS_VTCNA) + (size_t)l * 256 * 1024, 1024, b * 256, scr, (q / 8) * 64, (q % 8) * 32, lane, MapId()); }
        }
    }
    if (EN(2)) {
        PHASE_VARS();
        const float* cache_na_k = KIN(2); const float* cache_ckv = KIN(4); const float* cache_kr = KIN(5); const float* w_sgu = KIN(18);
        bf16* KCNA = WSP(bf16, WS_KCNA); bf16* CKVC = WSP(bf16, WS_CKVC); bf16* KRC = WSP(bf16, WS_KRC); bf16* WSGU = WSP(bf16, WS_WSGU); float* ROPE = WSP(float, WS_ROPE);
        for (int i = gt; i < 262144; i += NGT) {
            const int e = i * 4, c4 = e & 255, key = (e >> 8) & 255, l = (e >> 16) & 3, b = e >> 18;
            const size_t dd = ((size_t)(l * 4 + b) * 256 + key) * 256 + c4;
            *(u32x2*)(KCNA + dd) = pack4(*(const f32x4*)(cache_na_k + e)); *(u32x2*)(CKVC + dd) = pack4(*(const f32x4*)(cache_ckv + e));
        }
        for (int i = gt; i < 32768; i += NGT) {
            const int e = i * 4, c4 = e & 31, key = (e >> 5) & 255, l = (e >> 13) & 3, b = e >> 15;
            *(u32x2*)(KRC + ((size_t)(l * 4 + b) * 256 + key) * 32 + c4) = pack4(*(const f32x4*)(cache_kr + e));
        }
        for (int i = gt; i < 65536; i += NGT) *(u32x2*)(WSGU + (size_t)i * 4) = pack4(*(const f32x4*)(w_sgu + (size_t)i * 4));
        for (int i = gt; i < 512; i += NGT) { const int pos = i >> 3, f = i & 7; const float inv = powf(10000.0f, -(float)f / 8.0f); const float ang = (float)pos * inv; ROPE[2 * i] = cosf(ang); ROPE[2 * i + 1] = sinf(ang); }
    }
    GRID_BAR();
    if (EN(3)) {
        PHASE_VARS();
        const bf16* WIN = WSP(bf16, WS_WIN); const bf16* WF1 = WSP(bf16, WS_WF1); const float* MODS = WSP(float, WS_MODS); float* B1 = WSP(float, WS_B1); float* B2 = WSP(float, WS_B2);
        for (int it = gw; it < DEPTH * (NINP + NFF); it += NGW) {
            const int l = it / (NINP + NFF), cc = it % (NINP + NFF);
            const bf16* wrow; const float* sh; float* dst; int dstride;
            if (cc < NINP) { wrow = WIN + ((size_t)l * NINP + cc) * 1024; sh = MODS + (size_t)l * 5 * NMOD; dst = B1 + (size_t)l * 5 * NINP + cc; dstride = NINP; }
            else { wrow = WF1 + ((size_t)l * NFF + (cc - NINP)) * 1024; sh = MODS + (size_t)l * 5 * NMOD + 3072; dst = B2 + (size_t)l * 5 * NFF + (cc - NINP); dstride = NFF; }
            const v4u w0 = *(const v4u*)(wrow + 16 * lane), w1 = *(const v4u*)(wrow + 16 * lane + 8);
            const float wf[16] = {bflo(w0.x), bfhi(w0.x), bflo(w0.y), bfhi(w0.y), bflo(w0.z), bfhi(w0.z), bflo(w0.w), bfhi(w0.w),
                                  bflo(w1.x), bfhi(w1.x), bflo(w1.y), bfhi(w1.y), bflo(w1.z), bfhi(w1.z), bflo(w1.w), bfhi(w1.w)};
#pragma unroll
            for (int r = 0; r < 5; ++r) { const f32x4* sp = (const f32x4*)(sh + (size_t)r * NMOD + 16 * lane); float s = 0.f;
#pragma unroll
                for (int q = 0; q < 4; ++q) { const f32x4 v = sp[q]; s += (v.x * wf[4 * q] + v.y * wf[4 * q + 1]) + (v.z * wf[4 * q + 2] + v.w * wf[4 * q + 3]); }
                s = wave_sum(s); if (lane == 0) dst[(size_t)r * dstride] = s; }
        }
    }
    if (EN(4)) {
        PHASE_VARS();
        const float* x_prompt = KIN(0); const float* x_sample = KIN(1); const float* g_mix = KIN(10); const float* MODS = WSP(float, WS_MODS); bf16* XA = WSP(bf16, WS_XA); float* SSQX = WSP(float, WS_SSQX);
        for (int m = gw; m < MT; m += NGW) {
            const float* xr = (m < NCTX) ? x_prompt + (size_t)m * DM : x_sample + (size_t)(m - NCTX) * DM;
            const int r = (m < NCTX) ? 0 : 1 + ((m - NCTX) >> 11);
            const float* sc1 = MODS + (size_t)r * NMOD + 1024;
            float ss = 0.f;
#pragma unroll
            for (int j = 0; j < 4; ++j) { const int col = 4 * lane + 256 * j; const f32x4 v = *(const f32x4*)(xr + col); ss += sq4(v);
                const f32x4 gm = *(const f32x4*)(g_mix + col) * (*(const f32x4*)(sc1 + col) + 1.0f);
                *(u32x2*)(XA + (size_t)m * DM + col) = pack4(v * gm); }
            ss = wave_sum(ss);
            if (lane < 16) SSQX[(size_t)m * 16 + lane] = (lane == 0) ? ss : 0.f;
        }
    }
    GRID_BAR();

    for (int l = 0; l < DEPTH; ++l) {
        if (EN(5)) {
            PHASE_VARS();
            pg8::Gemm g{WSP(bf16, WS_XA), WSP(bf16, WS_WIN) + (size_t)l * NINP * 1024, MT, NINP, 1024}; pg8::StaticOrder S; S.init(MT, NINP, G, bx);
            EpiIn E; E.l = l; E.ws = ws; E.out = KOUT(); E.g_ckv = KIN(15) + l * 256; E.g_sgu = KIN(17) + l * 256; E.g_cq = KIN(13) + l * 384;
            pg8::gemm_phase<EpiIn, pg8::StaticOrder, true, true>(lds, g, S, E, wave);
        }
        GRID_BAR();
        if (EN(6)) {
            PHASE_VARS();
            pg8::Gemm g{WSP(bf16, WS_CQ), WSP(bf16, WS_WUQ) + (size_t)l * 768 * 384, MT, 768, 384}; pg8::StaticOrder S; S.init(MT, 768, G, bx);
            EpiQ E; E.ws = ws;
            pg8::gemm_phase<EpiQ, pg8::StaticOrder, true, true>(lds, g, S, E, wave);
        }
        if (EN(7)) for (int part = 0; part < 2; ++part) {
            PHASE_VARS();
            pg8::Gemm g; EpiKV E; pg8::StaticOrder S;
            g.Bt = WSP(bf16, WS_WUKV) + (size_t)l * 1024 * 256; g.N = 1024; g.K = 256;
            if (part == 0) { g.A = WSP(bf16, WS_CKV); g.M = MT; E.ssq1 = WSP(float, WS_SSQ1); E.K = WSP(bf16, WS_KMLA); E.VT = WSP(bf16, WS_VTMLA); E.vtpitch = MT; }
            else { g.A = WSP(bf16, WS_CKVC) + (size_t)l * 1024 * 256; g.M = 1024; E.ssq1 = nullptr; E.K = WSP(bf16, WS_KCMLA) + (size_t)l * 1024 * 512; E.VT = WSP(bf16, WS_VTCMLA) + (size_t)l * 512 * 1024; E.vtpitch = 1024; }
            S.init(g.M, 1024, G, bx);
            pg8::gemm_phase<EpiKV, pg8::StaticOrder, true, true>(lds, g, S, E, wave);
        }
        if (EN(8)) {
            PHASE_VARS(); float* out = KOUT();
            float* RSV = WSP(float, WS_RSV); const float* SSQ1 = WSP(float, WS_SSQ1);
            for (int m = gt; m < MT; m += NGT) RSV[m] = rsqrtf(sum4(*(const f32x4*)(SSQ1 + (size_t)m * 16 + 4)) * (1.0f / 256.0f) + EPS);
            for (int i = gt; i < NCTX * 64; i += NGT) { const int row = i >> 6, c4 = (i & 63) * 4, b = row >> 8, t = row & 255;
                const float rs = rsqrtf(sum4(*(const f32x4*)(SSQ1 + (size_t)row * 16)) * (1.0f / 256.0f) + EPS);
                f32x4* p = (f32x4*)(out + OUT_CKV + ((size_t)(b * 4 + l) * 256 + t) * 256 + c4); *p = *p * rs; }
        }
        GRID_BAR();
        if (EN(9)) {
            PHASE_VARS();
            LAS float* rpb = (LAS float*)(lds + LDS_RPB);
            { const float* na_rpb = KIN(12); for (int i = tid; i < 4 * 15 * 31; i += NTHR) rpb[i] = na_rpb[(size_t)l * 1860 + i] * LOG2E; }
            __syncthreads();
            P3Ptrs P; P.ws = ws; P.l = l; P.b_sgu = KIN(19) + l * 512;
            for (int u = gw; u < 2048; u += NGW) unit_mla_lat(P, u, lane);
            for (int i = gw; i < 4096; i += NGW) {
                if (i < 1024) unit_na_lat(P, i, lane, rpb);
                else if (i < 2048) unit_mla_ctx(P, i - 1024, lane);
                else if (i < 2560) unit_na_ctx(P, i - 2048, lane);
                else unit_sgu(P, i - 2560, lane);
            }
        }
        GRID_BAR();
        if (EN(10)) {
            PHASE_VARS(); float* out = KOUT();
            const float* modl = WSP(float, WS_MODS) + (size_t)l * 5 * NMOD;
            pg8::Gemm g{WSP(bf16, WS_MIX), WSP(bf16, WS_WOUT) + (size_t)l * 1024 * 1024, MT, 1024, 1024}; pg8::StaticOrder S; S.init(MT, 1024, G, bx);
            EpiRes E; E.base_ctx = (l == 0) ? KIN(0) : out; E.base_lat = (l == 0) ? KIN(1) : out + (size_t)NCTX * DM; E.xout = out; E.XA = WSP(bf16, WS_XA);
            E.gate = modl + 2048; E.gnext = KIN(21) + l * 1024; E.scnext = modl + 4096; E.ssqx = WSP(float, WS_SSQX);
            pg8::gemm_phase<EpiRes, pg8::StaticOrder, true, true>(lds, g, S, E, wave);
        }
        GRID_BAR();
        if (EN(11)) {
            PHASE_VARS();
            pg8::Gemm g{WSP(bf16, WS_XA), WSP(bf16, WS_WF1) + (size_t)l * NFF * 1024, MT, NFF, 1024}; pg8::StaticOrder S; S.init(MT, NFF, G, bx);
            EpiFF1 E; E.ssqx = WSP(float, WS_SSQX); E.bias = WSP(float, WS_B2) + (size_t)l * 5 * NFF; E.AFF = WSP(bf16, WS_AFF);
            pg8::gemm_phase<EpiFF1, pg8::StaticOrder, true, true>(lds, g, S, E, wave);
        }
        GRID_BAR();
        if (EN(12)) {
            PHASE_VARS();
            const float* cw = KIN(23) + (size_t)l * 3 * NFF; const float* cb = KIN(24) + (size_t)l * NFF;
            const bf16* AFF = WSP(bf16, WS_AFF); bf16* ACT = WSP(bf16, WS_ACT);
            for (int task = gt; task < (MT / 16) * (DFF / 8); task += NGT) {
                const int cg = task % (DFF / 8), rc = task / (DFF / 8); const int c0 = cg * 8, m0 = rc * 16;
                const int seqpos0 = (m0 < NCTX) ? (m0 & 255) : ((m0 - NCTX) & 2047); const int seqlen = (m0 < NCTX) ? 256 : 2048;
                float wg[3][8], wv[3][8], bg[8], bvv[8];
#pragma unroll
                for (int i = 0; i < 3; ++i)
#pragma unroll
                    for (int q = 0; q < 2; ++q) { const f32x4 a = *(const f32x4*)(cw + (size_t)i * NFF + c0 + 4 * q), b = *(const f32x4*)(cw + (size_t)i * NFF + DFF + c0 + 4 * q);
#pragma unroll
                        for (int j = 0; j < 4; ++j) { wg[i][4 * q + j] = a[j]; wv[i][4 * q + j] = b[j]; } }
#pragma unroll
                for (int q = 0; q < 2; ++q) { const f32x4 a = *(const f32x4*)(cb + c0 + 4 * q), b = *(const f32x4*)(cb + DFF + c0 + 4 * q);
#pragma unroll
                    for (int j = 0; j < 4; ++j) { bg[4 * q + j] = a[j]; bvv[4 * q + j] = b[j]; } }
                const bf16* ap = AFF + (size_t)m0 * NFF + c0;
                v4u gp, gc, gn, vp, vc, vn;
                const v4u zero = {0u, 0u, 0u, 0u};
                gp = (seqpos0 > 0) ? *(const v4u*)(ap - NFF) : zero; vp = (seqpos0 > 0) ? *(const v4u*)(ap - NFF + DFF) : zero;
                gc = *(const v4u*)ap; vc = *(const v4u*)(ap + DFF);
#pragma unroll 2
                for (int i = 0; i < 16; ++i) {
                    const bool has_next = (seqpos0 + i + 1) < seqlen;
                    gn = has_next ? *(const v4u*)(ap + (size_t)(i + 1) * NFF) : zero; vn = has_next ? *(const v4u*)(ap + (size_t)(i + 1) * NFF + DFF) : zero;
                    float r[8];
#pragma unroll
                    for (int q = 0; q < 4; ++q) {
                        const float g0 = wg[0][2 * q] * bflo(gp[q]) + wg[1][2 * q] * bflo(gc[q]) + wg[2][2 * q] * bflo(gn[q]) + bg[2 * q];
                        const float g1 = wg[0][2 * q + 1] * bfhi(gp[q]) + wg[1][2 * q + 1] * bfhi(gc[q]) + wg[2][2 * q + 1] * bfhi(gn[q]) + bg[2 * q + 1];
                        const float v0 = wv[0][2 * q] * bflo(vp[q]) + wv[1][2 * q] * bflo(vc[q]) + wv[2][2 * q] * bflo(vn[q]) + bvv[2 * q];
                        const float v1 = wv[0][2 * q + 1] * bfhi(vp[q]) + wv[1][2 * q + 1] * bfhi(vc[q]) + wv[2][2 * q + 1] * bfhi(vn[q]) + bvv[2 * q + 1];
                        r[2 * q] = silu_f(g0) * v0; r[2 * q + 1] = silu_f(g1) * v1;
                    }
                    v4u o; o.x = cvtpk(r[0], r[1]); o.y = cvtpk(r[2], r[3]); o.z = cvtpk(r[4], r[5]); o.w = cvtpk(r[6], r[7]);
                    *(v4u*)(ACT + (size_t)(m0 + i) * DFF + c0) = o;
                    gp = gc; gc = gn; vp = vc; vc = vn;
                }
            }
        }
        GRID_BAR();
        if (EN(13)) {
            PHASE_VARS(); float* out = KOUT();
            const float* modl = WSP(float, WS_MODS) + (size_t)l * 5 * NMOD;
            pg8::Gemm g{WSP(bf16, WS_ACT), WSP(bf16, WS_WF2) + (size_t)l * 1024 * DFF, MT, 1024, DFF}; pg8::StaticOrder S; S.init(MT, 1024, G, bx);
            const int ln = (l + 1 < DEPTH) ? l + 1 : l;
            EpiRes E; E.base_ctx = out; E.base_lat = out + (size_t)NCTX * DM; E.xout = out; E.XA = (l + 1 < DEPTH) ? WSP(bf16, WS_XA) : nullptr;
            E.gate = modl + 5120; E.gnext = KIN(10) + ln * 1024; E.scnext = WSP(float, WS_MODS) + (size_t)ln * 5 * NMOD + 1024; E.ssqx = WSP(float, WS_SSQX);
            pg8::gemm_phase<EpiRes, pg8::StaticOrder, true, true>(lds, g, S, E, wave);
        }
        GRID_BAR();
    }
    if (EN(14)) {
        PHASE_VARS(); float* out = KOUT();
        const float* g_final = KIN(26); const float* SSQX = WSP(float, WS_SSQX);
        for (int m = gw; m < MT; m += NGW) {
            float* xr = out + (size_t)m * DM;
            const float rstd = rsqrtf(sum16f(SSQX + (size_t)m * 16) * (1.0f / 1024.0f) + EPS);
#pragma unroll
            for (int j = 0; j < 4; ++j) { const int col = 4 * lane + 256 * j; const f32x4 v = *(const f32x4*)(xr + col) * rstd * *(const f32x4*)(g_final + col); *(f32x4*)(xr + col) = v; }
        }
    }
#undef GRID_BAR
}

extern "C" void kernel_launch(void* const* d_in, const int* in_sizes, int n_in, void* d_out, int out_size, void* d_ws, size_t ws_size, hipStream_t stream) {
    static int grid = 0;
    if (grid == 0) {
        if (n_in != 27 || out_size != (int)OUT_END || ws_size < WS_END) { fprintf(stderr, "kernel_launch: unexpected sizes (n_in %d, out %d, ws %zu; need 27, %zu, >= %zu)\n", n_in, out_size, ws_size, (size_t)OUT_END, (size_t)WS_END); grid = -1; return; }
        int dev = 0, cus = 0, per_cu = 0;
        if (hipGetDevice(&dev) != hipSuccess || hipDeviceGetAttribute(&cus, hipDeviceAttributeMultiprocessorCount, dev) != hipSuccess) { grid = -1; return; }
        if (hipFuncSetAttribute((const void*)fwd_megakernel, hipFuncAttributeMaxDynamicSharedMemorySize, LDS_BYTES) != hipSuccess) { fprintf(stderr, "kernel_launch: hipFuncSetAttribute failed\n"); grid = -1; return; }
        if (hipOccupancyMaxActiveBlocksPerMultiprocessor(&per_cu, (const void*)fwd_megakernel, NTHR, LDS_BYTES) != hipSuccess || per_cu < 1) { fprintf(stderr, "kernel_launch: occupancy query says %d blocks per CU\n", per_cu); per_cu = 1; }
        (void)hipGetLastError();
        grid = cus;
    }
    if (grid < 0) return;
    (void)hipMemsetAsync((char*)d_ws + WS_CTL, 0, CTL_ZERO_BYTES, stream);
    Args a{};
    for (int i = 0; i < 27; ++i) a.in[i] = (const float*)d_in[i];
    a.out = (float*)d_out; a.ws = (unsigned char*)d_ws; a.nphase_lo = 0; a.nphase_hi = 0;
    hipLaunchKernelGGL(fwd_megakernel, dim3(grid), dim3(NTHR), LDS_BYTES, stream, a);
}
```

```cpp
#include <hip/hip_runtime.h>
#include <cstdio>
#include <cstdint>
namespace pg8 {
#define PG8_LAS __attribute__((address_space(3)))
typedef unsigned short bf16_t;
typedef short bf16x8 __attribute__((ext_vector_type(8)));
typedef float f32x4 __attribute__((ext_vector_type(4)));
typedef unsigned u32x4 __attribute__((ext_vector_type(4)));
constexpr int BM = 256, BK = 64, HALF = 128, HTB = HALF * BK * 2  , STAGE_BYTES = 8 * HTB, NXCD = 8, WGM = 8;

__host__ __device__ __forceinline__ int lds_byte(int r, int c) { const int st = (r >> 4) * 2 + (c >> 5), rr = r & 15, cc = c & 31, ob = rr * 64 + cc * 2; return st * 1024 + (ob ^ (((ob >> 9) & 1) << 5)); }
__host__ __device__ __forceinline__ void stage_rc(int b, int& R, int& C) { const int st = b / 1024, sb = b % 1024, swz = sb ^ (((sb >> 9) & 1) << 5); R = (st >> 1) * 16 + swz / 64; C = (st & 1) * 32 + (swz % 64) / 2; }
__host__ __device__ __forceinline__ int perm32(int rho) { const int n = rho >> 4, i = rho & 15; return 8 * (i >> 2) + 4 * n + (i & 3); }

struct Unit { int pm, pn; };
struct Gemm { const bf16_t* A; const bf16_t* Bt; int M, N, K; };

struct StaticOrder {
    static constexpr bool SK = false;
    int nM, nN, nwg, G, c;
    __host__ __device__ __forceinline__ void init(int M, int N, int G_, int c_) { nM = M / BM; nN = N / BM; nwg = nM * nN; G = G_; c = c_; }
    __host__ __device__ __forceinline__ bool next(int i, Unit& u) const {
        const long L = (long)i * G + c; if (L >= nwg) return false;
        int wgid = (int)L; { const int q = nwg / NXCD, r = nwg % NXCD, xcd = wgid % NXCD, off = wgid / NXCD; wgid = (xcd < r ? xcd * (q + 1) : r * (q + 1) + (xcd - r) * q) + off; }
        const int nig = WGM * nN, gid = wgid / nig, fm = gid * WGM, gsz = (nM - fm) < WGM ? (nM - fm) : WGM;
        u.pm = fm + ((wgid % nig) % gsz); u.pn = (wgid % nig) / gsz; return true;
    }
    __device__ __forceinline__ void a_ready(const Unit&, int) const {}
    __device__ __forceinline__ void done(const Unit&) const {}
};
struct SchedSK5 {
    static constexpr bool SK = true;
    int x, g, jj, bx, i0, i1; unsigned* flags; float* part;
    __device__ __forceinline__ void init(int bx_, unsigned* flags_, float* part_, bool tail_call) { bx = bx_; x = bx_ & 7; g = bx_ >> 6; jj = (bx_ >> 3) & 7; flags = flags_; part = part_;
        const int np = jj > 0 ? 1 : 0; i0 = tail_call ? 0 : np; i1 = tail_call ? np : 5; }
    __device__ __forceinline__ bool next(int i_, Unit& u) const {
        const int i = i0 + i_; if (i >= i1) return false;
        const int q = 4 * jj + i; int rho, panel;
        if (q < 32) { panel = q >> 2; rho = ((x & 1) ? (33 * x + 1) / 2 : (33 * x) / 2) + 4 * (q & 3) + g; }
        else { panel = (x & 1) ? 4 + g : g; rho = (x & 1) ? (33 * x - 1) / 2 : (33 * x) / 2 + 16; }
        const int gam = rho / 22; u.pn = rho - 22 * gam; u.pm = 8 * gam + panel; return true;
    }
    __device__ __forceinline__ void piece(int i_, int& kb, int& nt, int& mode) const {
        const int i = i0 + i_; kb = 0; nt = 16; mode = 0;
        if (i == 0 && jj > 0) { kb = 2 * jj; nt = 16 - 2 * jj; mode = 1; }
        if (i == 4 && jj < 7) { nt = 2 * jj + 2; mode = 2; }
    }
    __device__ __forceinline__ float* slot_out() const { return part + (size_t)bx * 65536; }
    __device__ __forceinline__ unsigned* flag_out() const { return flags + bx; }
    __device__ __forceinline__ const float* slot_in() const { return part + (size_t)(bx + 8) * 65536; }
    __device__ __forceinline__ unsigned* flag_in() const { return flags + bx + 8; }
    __device__ __forceinline__ void a_ready(const Unit&, int) const {}
    __device__ __forceinline__ void done(const Unit&) const {}
};
struct SchedAssist {
    static constexpr bool SK = true;
    StaticOrder so; int c0, n, kb, ntp;
    __device__ __forceinline__ void init(int M, int N, int G, int bx, int KT, int KH) { if (bx < 192) { c0 = bx; n = 1; kb = 0; ntp = KT - KH; } else { c0 = (bx & 7) + 24 * ((bx - 192) >> 3); n = 3; kb = KT - KH; ntp = KH; } so.init(M, N, G, 0); }
    __device__ __forceinline__ bool next(int i, Unit& u) const { if (i >= n) return false; StaticOrder s2 = so; s2.c = c0 + 8 * i; return s2.next(0, u); }
    __device__ __forceinline__ void piece(int, int& kb_, int& nt_, int& mode) const { kb_ = kb; nt_ = ntp; mode = 0; }
    __device__ __forceinline__ float* slot_in() const { return nullptr; }
    __device__ __forceinline__ unsigned* flag_in() const { return nullptr; }
    __device__ __forceinline__ void a_ready(const Unit&, int) const {}
    __device__ __forceinline__ void done(const Unit&) const {}
};
struct SchedP1 {
    static constexpr bool SK = false;
    int x, p, s;
    __device__ __forceinline__ void init(int bx) { x = bx & 7; p = (bx >> 3) & 7; s = bx >> 6; }
    __device__ __forceinline__ bool next(int i, Unit& u) const {
        if (i > 1 || (i == 1 && s >= 2)) return false;
        const int ci = s < 2 ? 2 * s + i : s + 2;
        const unsigned pat = (x & 3) == 0 ? 0x542130u : (x & 3) == 1 ? 0xA7968Bu : (x & 3) == 2 ? 0x549687u : 0x543267u;
        const int nib = (int)((pat >> (4 * ci)) & 15u);
        u.pm = 8 * (((6 * x) >> 3) + (nib >> 3)) + p; u.pn = nib & 7; return true;
    }
    __device__ __forceinline__ void a_ready(const Unit&, int) const {}
    __device__ __forceinline__ void done(const Unit&) const {}
};

__device__ __forceinline__ int pg8_lane_id_v() { int l; asm volatile("v_mbcnt_lo_u32_b32 %0, -1, 0\n\tv_mbcnt_hi_u32_b32 %0, -1, %0" : "=v"(l)); return l; }
__device__ __forceinline__ int pg8_lane_id() { return (int)__builtin_amdgcn_mbcnt_hi(~0u, __builtin_amdgcn_mbcnt_lo(~0u, 0u)); }
typedef unsigned long long sk_u64;
typedef unsigned long long sk_u64x2 __attribute__((ext_vector_type(2)));
typedef float sk_f32x2 __attribute__((ext_vector_type(2)));
typedef __bf16 sk_bf16x2 __attribute__((ext_vector_type(2)));
typedef unsigned sk_u32x2 __attribute__((ext_vector_type(2)));
__device__ __forceinline__ sk_u64 sk_pack(const f32x4& v) { sk_f32x2 a = {v.x, v.y}, c = {v.z, v.w}; sk_u32x2 w;
    w.x = __builtin_bit_cast(unsigned, __builtin_convertvector(a, sk_bf16x2)); w.y = __builtin_bit_cast(unsigned, __builtin_convertvector(c, sk_bf16x2)); return __builtin_bit_cast(sk_u64, w); }
__device__ __forceinline__ f32x4 sk_unpack(sk_u64 q) { const sk_u32x2 w = __builtin_bit_cast(sk_u32x2, q); f32x4 v;
    v.x = __builtin_bit_cast(float, w.x << 16); v.y = __builtin_bit_cast(float, w.x & 0xffff0000u); v.z = __builtin_bit_cast(float, w.y << 16); v.w = __builtin_bit_cast(float, w.y & 0xffff0000u); return v; }
__device__ __forceinline__ void sk_store(const f32x4 (&acc)[2][2][4][2], float* slot, unsigned* flag, int wid) {
    const int lane = pg8_lane_id_v(); const unsigned o = (unsigned)(wid * 64 + lane) * 16u;
    const __amdgpu_buffer_rsrc_t rs = __builtin_amdgcn_make_buffer_rsrc(slot, 0, 131072, 0x00020000);
#pragma unroll
    for (int a = 0; a < 2; ++a)
#pragma unroll
        for (int b = 0; b < 2; ++b) {
            asm volatile("" ::: "memory"); __builtin_amdgcn_sched_barrier(0);
#pragma unroll
            for (int m = 0; m < 4; ++m) { const unsigned i = (unsigned)((a * 2 + b) * 4 + m); sk_u64x2 w; w.x = sk_pack(acc[a][b][m][0]); w.y = sk_pack(acc[a][b][m][1]);
                __builtin_amdgcn_raw_buffer_store_b128(__builtin_bit_cast(u32x4, w), rs, o + i * 8192u, 0,   16); }
        }
    asm volatile("s_waitcnt vmcnt(0)" ::: "memory");
    __builtin_amdgcn_s_barrier();
    if (wid == 0 && lane == 0) __hip_atomic_store(flag, 1u, __ATOMIC_RELAXED, __HIP_MEMORY_SCOPE_AGENT);
}
__device__ __forceinline__ void sk_load_init(f32x4 (&acc)[2][2][4][2], const float* slot, unsigned* flag, int wid) {
    const int lane = pg8_lane_id_v();
    if (wid == 0 && lane == 0) { unsigned sp = 0;
        while (__hip_atomic_load(flag, __ATOMIC_RELAXED, __HIP_MEMORY_SCOPE_AGENT) == 0u) { __builtin_amdgcn_s_sleep(1); if (++sp > (1u << 22)) break; }
        asm volatile("s_waitcnt vmcnt(0)" ::: "memory"); }
    __builtin_amdgcn_s_barrier();
    const unsigned o = (unsigned)(wid * 64 + lane) * 16u;
    const __amdgpu_buffer_rsrc_t rs = __builtin_amdgcn_make_buffer_rsrc((void*)slot, 0, 131072, 0x00020000);
#pragma unroll
    for (int a = 0; a < 2; ++a)
#pragma unroll
        for (int b = 0; b < 2; ++b)
#pragma unroll
            for (int m = 0; m < 4; ++m) { const unsigned i = (unsigned)((a * 2 + b) * 4 + m);
                const sk_u64x2 w = __builtin_bit_cast(sk_u64x2, __builtin_amdgcn_raw_buffer_load_b128(rs, o + i * 8192u, 0,   16));
                acc[a][b][m][0] = sk_unpack(w.x); acc[a][b][m][1] = sk_unpack(w.y); }
}
struct EpiPartOut {
    static constexpr bool PERM = true, AFTER_DRAIN = false;
    float* slot; unsigned* flag; int step;
    __device__ __forceinline__ void prefill(const Unit&, int, int, int, int) const {}
    __device__ __forceinline__ void operator()(const f32x4 (&acc)[2][2][4][2], const Unit&, int wr, int wc, int, int, int ui, const Unit&) const { sk_store(acc, slot + (size_t)(ui * step) * 65536, flag + ui * step, wr * 4 + wc); }
};
template <class Epi, class Sched, bool ALIGN_EPI = false, bool SP2 = false>
__device__ __forceinline__ void gemm_phase(PG8_LAS unsigned char* lds, const Gemm g, const Sched& S, const Epi& E, const int wid_in) {
    const int lane = pg8_lane_id_v(), wid = wid_in, tid = wid * 64 + lane, wr = wid >> 2, wc = wid & 3, fr = lane & 15, fq = lane >> 4;
    const int K = g.K; int nt = K / BK;
    unsigned voffA[2], voffB[2];
#define PG8_LANE_OFFS(tid_) do { _Pragma("unroll") for (int i = 0; i < 2; ++i) { int R, C; stage_rc((tid_) * 16 + i * 8192, R, C); const int Rb = Epi::PERM ? ((R & ~31) + perm32(R & 31)) : R; \
        voffA[i] = (unsigned)(R * K + C) * 2u; voffB[i] = (unsigned)(Rb * K + C) * 2u; } } while (0)
    PG8_LANE_OFFS(tid);
    const size_t kstep = (size_t)(BK * 2);
    const size_t hstep = (size_t)HALF * K * 2;
    const size_t tstep = 2 * hstep;
    const unsigned ldsw = (unsigned)wid * 1024u;
    int aoff = lds_byte(wr * 64 + fr, fq * 8), boff = lds_byte(wc * 32 + fr, fq * 8);
#define PG8_SA(b, h) (((b) * 2 + (h)) * HTB)
#define PG8_SB(b, h) ((4 + (b) * 2 + (h)) * HTB)
#define PG8_STAGE(bufoff, gbase, voff) do { _Pragma("unroll") for (int _i = 0; _i < 2; ++_i) \
        __builtin_amdgcn_global_load_lds((const unsigned*)((const char*)(gbase) + (voff)[_i]), (PG8_LAS unsigned*)(lds + (bufoff) + ldsw + _i * 8192), 16, 0, 0); } while (0)
#define PG8_LDA(dst, b, h) do { _Pragma("unroll") for (int m = 0; m < 4; ++m) _Pragma("unroll") for (int k = 0; k < 2; ++k) dst[m][k] = *(const PG8_LAS bf16x8*)(lds + PG8_SA(b, h) + aoff + m * 2048 + k * 1024); } while (0)
#define PG8_LDB(dst, b, h) do { _Pragma("unroll") for (int n = 0; n < 2; ++n) _Pragma("unroll") for (int k = 0; k < 2; ++k) dst[n][k] = *(const PG8_LAS bf16x8*)(lds + PG8_SB(b, h) + boff + n * 2048 + k * 1024); } while (0)
#define PG8_MMA(ai, bj, At, Bt) do { __builtin_amdgcn_s_setprio(1); _Pragma("unroll") for (int m = 0; m < 4; ++m) _Pragma("unroll") for (int n = 0; n < 2; ++n) _Pragma("unroll") for (int k = 0; k < 2; ++k) \
        acc[ai][bj][m][n] = __builtin_amdgcn_mfma_f32_16x16x32_bf16(Bt[n][k], At[m][k], acc[ai][bj][m][n], 0, 0, 0); __builtin_amdgcn_s_setprio(0); } while (0)
#define PG8_WAIT_V(n) asm volatile("s_waitcnt vmcnt(" #n ")" ::: "memory")
#define PG8_WAIT_L(n) asm volatile("s_waitcnt lgkmcnt(" #n ")" ::: "memory")
#define PG8_BAR __builtin_amdgcn_s_barrier()
#define PG8_SCHED __builtin_amdgcn_sched_barrier(0)
    Unit cur, nxt; int ui = 0;
    if (!S.next(0, cur)) return;
    f32x4 acc[2][2][4][2];
#pragma unroll
    for (int a = 0; a < 2; ++a)
#pragma unroll
        for (int b = 0; b < 2; ++b)
#pragma unroll
            for (int m = 0; m < 4; ++m)
#pragma unroll
                for (int n = 0; n < 2; ++n) acc[a][b][m][n] = (f32x4){0.f, 0.f, 0.f, 0.f};
    bf16x8 At[4][2], B0[2][2], B1[2][2];
    const char* cA = (const char*)g.A + (size_t)cur.pm * tstep; const char* cB = (const char*)g.Bt + (size_t)cur.pn * tstep;
    int nt_n = nt, md_n = 0;
    if constexpr (Sched::SK) { int kb, md; S.piece(0, kb, nt, md); cA += (size_t)kb * kstep; cB += (size_t)kb * kstep; }
    S.a_ready(cur, 0);
    if constexpr (!Epi::AFTER_DRAIN) E.prefill(cur, wr, wc, fr, fq);
    if constexpr (SP2) {
        PG8_STAGE(PG8_SB(0, 0), cB, voffB); PG8_STAGE(PG8_SB(0, 1), cB + hstep, voffB); PG8_STAGE(PG8_SA(0, 0), cA, voffA); PG8_STAGE(PG8_SA(0, 1), cA + hstep, voffA);
        if (wr == 1) PG8_BAR;
        PG8_WAIT_V(2); PG8_BAR;
        PG8_STAGE(PG8_SB(1, 0), cB + kstep, voffB); PG8_STAGE(PG8_SA(1, 0), cA + kstep, voffA); PG8_STAGE(PG8_SB(1, 1), cB + hstep + kstep, voffB);
        PG8_WAIT_V(6); PG8_BAR;
    } else {
        PG8_STAGE(PG8_SB(0, 0), cB, voffB); PG8_STAGE(PG8_SA(0, 0), cA, voffA); PG8_STAGE(PG8_SB(0, 1), cB + hstep, voffB); PG8_STAGE(PG8_SA(0, 1), cA + hstep, voffA);
        if (wr == 1) PG8_BAR;
        PG8_WAIT_V(4); PG8_BAR;
        PG8_STAGE(PG8_SB(1, 0), cB + kstep, voffB); PG8_STAGE(PG8_SA(1, 0), cA + kstep, voffA); PG8_STAGE(PG8_SB(1, 1), cB + hstep + kstep, voffB);
        PG8_WAIT_V(6); PG8_BAR;
    }
    for (;;) {
        const bool has_next = S.next(ui + 1, nxt);
        if (!has_next) nxt = cur;
        const char* nA = has_next ? (const char*)g.A + (size_t)nxt.pm * tstep : cA; const char* nB = has_next ? (const char*)g.Bt + (size_t)nxt.pn * tstep : cB;
        if constexpr (Sched::SK) { if (has_next) { int kb; S.piece(ui + 1, kb, nt_n, md_n); nA += (size_t)kb * kstep; nB += (size_t)kb * kstep; } }
        for (int t = 0; t < nt; t += 2) {
            const bool last = (t == nt - 2);
            const char* a1 = cA + (size_t)(t + 1) * kstep;
            const char* a2 = last ? nA : cA + (size_t)(t + 2) * kstep; const char* b2 = last ? nB : cB + (size_t)(t + 2) * kstep;
            const char* a3 = a2 + kstep; const char* b3 = b2 + kstep;
            if (last && has_next) S.a_ready(nxt, ui + 1);
            if constexpr (SP2) {
            PG8_LDB(B0, 0, 0); PG8_LDB(B1, 0, 1); PG8_SCHED; PG8_LDA(At, 0, 0); PG8_STAGE(PG8_SA(1, 1), a1 + hstep, voffA);
            PG8_WAIT_V(8); PG8_WAIT_L(0); PG8_BAR; PG8_MMA(0, 0, At, B0); PG8_MMA(0, 1, At, B1); PG8_BAR; PG8_SCHED;
            PG8_LDA(At, 0, 1); PG8_STAGE(PG8_SB(0, 0), b2, voffB); PG8_STAGE(PG8_SB(0, 1), b2 + hstep, voffB); PG8_STAGE(PG8_SA(0, 0), a2, voffA);
            PG8_WAIT_V(8); PG8_WAIT_L(0); PG8_BAR; PG8_MMA(1, 0, At, B0); PG8_MMA(1, 1, At, B1); PG8_BAR; PG8_SCHED;
            PG8_LDB(B0, 1, 0); PG8_LDB(B1, 1, 1); PG8_SCHED; PG8_LDA(At, 1, 0); PG8_STAGE(PG8_SA(0, 1), a2 + hstep, voffA);
            PG8_WAIT_V(8); PG8_WAIT_L(0); PG8_BAR; PG8_MMA(0, 0, At, B0); PG8_MMA(0, 1, At, B1); PG8_BAR; PG8_SCHED;
            PG8_LDA(At, 1, 1); PG8_STAGE(PG8_SB(1, 0), b3, voffB); PG8_STAGE(PG8_SB(1, 1), b3 + hstep, voffB); PG8_STAGE(PG8_SA(1, 0), a3, voffA);
            PG8_WAIT_V(8); PG8_WAIT_L(0); PG8_BAR; PG8_MMA(1, 0, At, B0); PG8_MMA(1, 1, At, B1); PG8_BAR; PG8_SCHED;
            } else {
            PG8_LDB(B0, 0, 0); PG8_SCHED; PG8_LDA(At, 0, 0); PG8_STAGE(PG8_SA(1, 1), a1 + hstep, voffA);
            PG8_WAIT_L(8); PG8_BAR; PG8_WAIT_L(0); PG8_MMA(0, 0, At, B0); PG8_BAR; PG8_SCHED;
            PG8_LDB(B1, 0, 1); PG8_STAGE(PG8_SB(0, 0), b2, voffB);
            PG8_BAR; PG8_WAIT_L(0); PG8_MMA(0, 1, At, B1); PG8_BAR;
            PG8_LDA(At, 0, 1); PG8_STAGE(PG8_SA(0, 0), a2, voffA);
            PG8_BAR; PG8_WAIT_L(0); PG8_MMA(1, 0, At, B0); PG8_BAR; PG8_SCHED;
            PG8_STAGE(PG8_SB(0, 1), b2 + hstep, voffB);
            PG8_WAIT_V(6); PG8_BAR; PG8_MMA(1, 1, At, B1); PG8_BAR;
            PG8_LDB(B0, 1, 0); PG8_SCHED; PG8_LDA(At, 1, 0); PG8_STAGE(PG8_SA(0, 1), a2 + hstep, voffA);
            PG8_WAIT_L(8); PG8_BAR; PG8_WAIT_L(0); PG8_MMA(0, 0, At, B0); PG8_BAR; PG8_SCHED;
            PG8_LDB(B1, 1, 1); PG8_STAGE(PG8_SB(1, 0), b3, voffB);
            PG8_BAR; PG8_WAIT_L(0); PG8_MMA(0, 1, At, B1); PG8_BAR;
            PG8_LDA(At, 1, 1); PG8_STAGE(PG8_SA(1, 0), a3, voffA);
            PG8_BAR; PG8_WAIT_L(0); PG8_MMA(1, 0, At, B0); PG8_BAR; PG8_SCHED;
            PG8_STAGE(PG8_SB(1, 1), b3 + hstep, voffB);
            PG8_WAIT_V(6); PG8_BAR; PG8_MMA(1, 1, At, B1); PG8_BAR;
            }
        }
        if constexpr (ALIGN_EPI) { if (wr == 0) PG8_BAR; }
        if constexpr (!Epi::AFTER_DRAIN) { const int l2 = pg8_lane_id_v(); E(acc, cur, wr, wc, l2 & 15, l2 >> 4, ui, nxt); S.done(cur); }
        if (!has_next) break;
        bool zero = true;
        if constexpr (Sched::SK) { if (md_n == 2) { sk_load_init(acc, S.slot_in(), S.flag_in(), wid); zero = false; } }
        if (zero) {
#pragma unroll
        for (int a = 0; a < 2; ++a)
#pragma unroll
            for (int b = 0; b < 2; ++b)
#pragma unroll
                for (int m = 0; m < 4; ++m)
#pragma unroll
                    for (int n = 0; n < 2; ++n) acc[a][b][m][n] = (f32x4){0.f, 0.f, 0.f, 0.f};
        }
        cur = nxt; cA = nA; cB = nB; ++ui;
        { const int l3 = pg8_lane_id_v(); PG8_LANE_OFFS(wid * 64 + l3); aoff = lds_byte(wr * 64 + (l3 & 15), (l3 >> 4) * 8); boff = lds_byte(wc * 32 + (l3 & 15), (l3 >> 4) * 8); }
        if constexpr (Sched::SK) nt = nt_n;
        if constexpr (ALIGN_EPI) { if (wr == 1) PG8_BAR; }
    }
    PG8_WAIT_V(0);
    if constexpr (!ALIGN_EPI) { if (wr == 0) PG8_BAR; }
    PG8_BAR;
    if constexpr (Epi::AFTER_DRAIN) { E.fused(acc, cur, wr, wc, fr, fq, lds, wid, lane); S.done(cur); }
#undef PG8_LANE_OFFS
#undef PG8_SA
#undef PG8_SB
#undef PG8_STAGE
#undef PG8_LDA
#undef PG8_LDB
#undef PG8_MMA
#undef PG8_WAIT_V
#undef PG8_WAIT_L
#undef PG8_BAR
#undef PG8_SCHED
}
}

#define GAS __attribute__((address_space(1)))
#define LAS __attribute__((address_space(3)))
typedef unsigned short bf16;
typedef unsigned v4u __attribute__((ext_vector_type(4)));
typedef float f32x4 __attribute__((ext_vector_type(4)));
typedef short bf16x8 __attribute__((ext_vector_type(8)));
typedef GAS unsigned gu32;
typedef GAS unsigned long long gu64;
#define RLX_AGENT __ATOMIC_RELAXED, __HIP_MEMORY_SCOPE_AGENT
#define LDS_WAIT() asm volatile("s_waitcnt lgkmcnt(0)" ::: "memory")
#define VM_WAIT() asm volatile("s_waitcnt vmcnt(0)" ::: "memory")
__device__ __forceinline__ unsigned long long rt() { return __builtin_amdgcn_s_memrealtime(); }
__device__ __forceinline__ unsigned f2bf(float f) { unsigned u = __builtin_bit_cast(unsigned, f); return (u + 0x7fffu + ((u >> 16) & 1u)) >> 16; }
__device__ __forceinline__ unsigned pk2(float lo, float hi) { return f2bf(lo) | (f2bf(hi) << 16); }

#define XB_TMO      128
#define XB_XCNT(j)  (256  + 64 * (j))
#define XB_XSUB(j)  (1280 + 64 * (j))
#define XB_XGEN(j)  (2304 + 64 * (j))
#define XB_TOP      3328
#define XB_TOPGEN   3392
#define XCD_BAR_WORDS 3456
#define XB_SPIN_CAP (1u << 18)

__device__ __forceinline__ unsigned xb_ld(unsigned* p)              { return __hip_atomic_load(p, __ATOMIC_RELAXED, __HIP_MEMORY_SCOPE_AGENT); }
__device__ __forceinline__ unsigned xb_add(unsigned* p, unsigned v) { return __hip_atomic_fetch_add(p, v, __ATOMIC_RELAXED, __HIP_MEMORY_SCOPE_AGENT); }
__device__ __forceinline__ unsigned xb_xcc_id() { return (unsigned)__builtin_amdgcn_s_getreg((3 << 11) | 20) & 0xFu; }
#define XB_SPIN(cond, bar) do { unsigned _sp = 0; while (cond) { __builtin_amdgcn_s_sleep(1); \
    if ((++_sp & 255u) == 0u) { if (xb_ld(&(bar)[XB_TMO])) break; if (_sp > XB_SPIN_CAP) { atomicAdd(&(bar)[XB_TMO], 1u); break; } } } } while (0)

struct XcdBarrier {
    unsigned* bar; unsigned x;
    volatile LAS unsigned* st;
};

__device__ __forceinline__ XcdBarrier xcd_barrier_post(unsigned* bar, volatile LAS unsigned* st, const bool t0) {
    XcdBarrier b; b.bar = bar; b.x = xb_xcc_id(); b.st = st;
    if (t0) (void)xb_add(&bar[XB_XCNT(b.x)], 1u);
    return b;
}
__device__ __forceinline__ void xcd_barrier_complete(unsigned* bar, unsigned x, unsigned& nloc, unsigned& nx) {
    const unsigned G = gridDim.x * gridDim.y * gridDim.z;
    unsigned sum, cnt, mine, sp = 0u;
    for (;;) {
        sum = 0u; cnt = 0u; mine = 0u;
#pragma unroll
        for (unsigned j = 0; j < 16; ++j) { const unsigned c = xb_ld(&bar[XB_XCNT(j)]); sum += c; cnt += (c > 0u) ? 1u : 0u; mine = (j == x) ? c : mine; }
        if (sum == G) break;
        __builtin_amdgcn_s_sleep(1);
        if ((++sp & 255u) == 0u) { if (xb_ld(&bar[XB_TMO])) break; if (sp > XB_SPIN_CAP) { atomicAdd(&bar[XB_TMO], 1u); break; } }
    }
    nloc = mine > 0u ? mine : 1u; nx = cnt > 0u ? cnt : 1u;
}

__device__ __forceinline__ void xcd_barrier(const XcdBarrier& b, const bool t0) {
    asm volatile("s_waitcnt vmcnt(0)" ::: "memory");
    __syncthreads();
    if (t0) {
        unsigned* bar = b.bar;
        __builtin_amdgcn_s_waitcnt(0);
        unsigned nloc = b.st[0], nx = b.st[1];
        if (nloc == 0u) { xcd_barrier_complete(bar, b.x, nloc, nx); b.st[0] = nloc; b.st[1] = nx; }
        const unsigned old = xb_add(&bar[XB_XSUB(b.x)], 1u);
        const unsigned gen = old / nloc;
        if (old + 1u == (gen + 1u) * nloc) {
            __builtin_amdgcn_fence(__ATOMIC_RELEASE, "agent");
            asm volatile("s_waitcnt vmcnt(0)" ::: "memory");
            const unsigned og = xb_add(&bar[XB_TOP], 1u);
            const unsigned tg = og / nx;
            if (og + 1u == (tg + 1u) * nx) xb_add(&bar[XB_TOPGEN], 1u);
            else XB_SPIN(xb_ld(&bar[XB_TOPGEN]) == tg, bar);
            __builtin_amdgcn_fence(__ATOMIC_ACQUIRE, "agent");
            xb_add(&bar[XB_XGEN(b.x)], 1u);
            asm volatile("s_waitcnt vmcnt(0)" ::: "memory");
        } else {
            XB_SPIN(xb_ld(&bar[XB_XGEN(b.x)]) == gen, bar);
            __builtin_amdgcn_fence(__ATOMIC_ACQUIRE, "agent");
            asm volatile("s_waitcnt vmcnt(0)" ::: "memory");
        }
    }
    __syncthreads();
}


typedef float f32x16 __attribute__((ext_vector_type(16)));
typedef float f32x2 __attribute__((ext_vector_type(2)));
typedef unsigned u32x2 __attribute__((ext_vector_type(2)));
typedef __bf16 bf16x2_t __attribute__((ext_vector_type(2)));

constexpr int DM = 1024, NCTX = 4096, NLAT = 8192, MT = 12288, DEPTH = 4;
constexpr int NINP = 2048, NIN = 1952, DFF = 2816, NFF = 5632, NMOD = 6144;
constexpr float EPS = 1e-6f;
constexpr float LOG2E = 1.4426950408889634f;
constexpr float QS_NA = 0.125f * LOG2E;
constexpr float QS_MLA = 0.10206207261596575f * LOG2E;
constexpr float NEG_BIG = -1e30f;

constexpr size_t OUT_X = 0;
constexpr size_t OUT_NK = 12582912, OUT_NV = 16777216, OUT_CKV = 20971520, OUT_KR = 25165824, OUT_END = 25690112;

constexpr size_t KiB = 1024, MiB = 1u << 20;
constexpr size_t WS_CTL = 0, CTL_ZERO_BYTES = 1 * MiB;
constexpr size_t WS_ROPE = 1 * MiB;
constexpr size_t WS_MODS = WS_ROPE + 4 * KiB;
constexpr size_t WS_B1 = WS_MODS + 491520;
constexpr size_t WS_B2 = WS_B1 + 163840;
constexpr size_t WS_RSV = WS_B2 + 450560;
constexpr size_t WS_SSQX = WS_RSV + 49152;
constexpr size_t WS_SSQ1 = WS_SSQX + 786432;
constexpr size_t WS_WSGU = WS_SSQ1 + 786432;
static_assert(WS_WSGU + 524288 <= 8 * MiB, "ws map");
constexpr size_t WS_WIN = 8 * MiB;
constexpr size_t WS_WUQ = 24 * MiB;
constexpr size_t WS_WUKV = 27 * MiB;
constexpr size_t WS_WOUT = 29 * MiB;
constexpr size_t WS_WF1 = 37 * MiB;
constexpr size_t WS_XR = 49 * MiB;
constexpr size_t WS_WF2 = 81 * MiB;
constexpr size_t WS_KCNA = 103 * MiB;
constexpr size_t WS_VTCNA = 105 * MiB;
constexpr size_t WS_CKVC = 107 * MiB;
constexpr size_t WS_KRC = 109 * MiB;
constexpr size_t WS_KCMLA = 110 * MiB;
constexpr size_t WS_VTCMLA = 114 * MiB;
constexpr size_t WS_XA = 118 * MiB;
constexpr size_t WS_T = 142 * MiB;
constexpr size_t WS_QNA = WS_T, WS_KNA = WS_T + 6 * MiB, WS_VTNA = WS_T + 12 * MiB, WS_CQ = WS_T + 18 * MiB, WS_CKV = WS_T + 27 * MiB, WS_KR = WS_T + 33 * MiB,
                 WS_U = WS_T + 34 * MiB, WS_VTSGU = WS_T + 40 * MiB, WS_QMLA = WS_T + 46 * MiB, WS_KMLA = WS_T + 64 * MiB, WS_VTMLA = WS_T + 76 * MiB, WS_MIX = WS_T + 88 * MiB;
constexpr size_t WS_VFM = WS_T + 112 * MiB, WS_KRF = WS_T + 116 * MiB;
constexpr size_t WS_PART = WS_T;
constexpr int CW_SKF = 16384;
constexpr size_t WS_AFF = WS_T, WS_ACT = WS_T + 132 * MiB;
constexpr size_t WS_EDGE_A = WS_T + 198 * MiB;
constexpr size_t WS_EDGE_P = WS_T + 201 * MiB;
constexpr size_t WS_NABT = WS_T + 204 * MiB;
constexpr size_t WS_END = WS_T + 208 * MiB;
constexpr int CW_BAR = 4096;

constexpr int RING_BYTES = 131072;
constexpr int LDS_MISC = RING_BYTES;
constexpr int LDS_RPB = RING_BYTES + 256;
constexpr int LDS_WSCR = RING_BYTES + 8192;
constexpr int LDS_TAB = RING_BYTES + 24576;
constexpr int LDS_BYTES = RING_BYTES + 30720;
constexpr int NWAVES = 8, NTHR = 512;

struct Args {
    const float* in[27];
    float* out; unsigned char* ws;
    int nphase_lo, nphase_hi;
};

__device__ __forceinline__ unsigned cvtpk(float lo, float hi) { f32x2 v = {lo, hi}; bf16x2_t b = __builtin_convertvector(v, bf16x2_t); return __builtin_bit_cast(unsigned, b); }
__device__ __forceinline__ float bf2f(unsigned short b) { return __uint_as_float((unsigned)b << 16); }
__device__ __forceinline__ float bflo(unsigned w) { return __uint_as_float(w << 16); }
typedef _Float16 h16x2_t __attribute__((ext_vector_type(2)));
__device__ __forceinline__ unsigned cvtpkh(float lo, float hi) { h16x2_t h = {(_Float16)lo, (_Float16)hi}; return __builtin_bit_cast(unsigned, h); }
__device__ __forceinline__ float hlo(unsigned w) { const h16x2_t h = __builtin_bit_cast(h16x2_t, w); return (float)h.x; }
__device__ __forceinline__ float hhi(unsigned w) { const h16x2_t h = __builtin_bit_cast(h16x2_t, w); return (float)h.y; }
__device__ __forceinline__ float bfhi(unsigned w) { return __uint_as_float(w & 0xffff0000u); }
__device__ __forceinline__ float fast_exp2(float x) { return __builtin_amdgcn_exp2f(x); }
__device__ __forceinline__ float fast_rcp(float x) { return __builtin_amdgcn_rcpf(x); }
__device__ __forceinline__ float silu_f(float x) { return x * fast_rcp(1.0f + fast_exp2(-x * LOG2E)); }
__device__ __forceinline__ float gelu_tanh_f(float x) {
    const float u = 0.7978845608028654f * (x + 0.044715f * x * x * x);
    return x * fast_rcp(1.0f + fast_exp2(-2.0f * LOG2E * u));
}
__device__ __forceinline__ float xsum32(float v) { auto r = __builtin_amdgcn_permlane32_swap(__float_as_uint(v), __float_as_uint(v), false, false); return __uint_as_float(r[0]) + __uint_as_float(r[1]); }
__device__ __forceinline__ float xmax32(float v) { auto r = __builtin_amdgcn_permlane32_swap(__float_as_uint(v), __float_as_uint(v), false, false); return fmaxf(__uint_as_float(r[0]), __uint_as_float(r[1])); }
__device__ __forceinline__ float xsum16(float v) { auto r = __builtin_amdgcn_permlane16_swap(__float_as_uint(v), __float_as_uint(v), false, false); return __uint_as_float(r[0]) + __uint_as_float(r[1]); }
template <int CTRL> __device__ __forceinline__ float dpp_keep_f(float old, float v) { return __uint_as_float((unsigned)__builtin_amdgcn_update_dpp((int)__float_as_uint(old), (int)__float_as_uint(v), CTRL, 0xf, 0xf, false)); }
template <int CTRL> __device__ __forceinline__ float dpp_f(float v) { return __uint_as_float((unsigned)__builtin_amdgcn_update_dpp(0, (int)__float_as_uint(v), CTRL, 0xf, 0xf, true)); }
__device__ __forceinline__ float wave_sum(float v) {
    v += dpp_f<0xB1>(v);
    v += dpp_f<0x4E>(v);
    v += dpp_f<0x124>(v);
    v += dpp_f<0x128>(v);
    v = xsum16(v); v = xsum32(v);
    return v;
}

__host__ __device__ __forceinline__ unsigned kfrag_off(unsigned m, unsigned h, unsigned d8) { const unsigned kk = m & 31u, kp = (kk & ~12u) | ((kk & 8u) >> 1) | ((kk & 4u) << 1); return ((((m >> 5) * 4u + h) * 4u + (d8 >> 1)) * 64u + (d8 & 1u) * 32u + kp) * 8u; }
__host__ __device__ __forceinline__ unsigned vfrag_off(unsigned m8, unsigned h, unsigned d) { const unsigned k8 = (m8 & 31u) >> 3; return (((((m8 >> 5) * 4u + h) * 2u + (d >> 5)) * 2u + (k8 >> 1)) * 64u + (k8 & 1u) * 32u + (d & 31u)) * 8u; }
__host__ __device__ __forceinline__ unsigned kfrag8_off(unsigned m, unsigned h, unsigned d8) { const unsigned kk = m & 31u, kp = (kk & ~12u) | ((kk & 8u) >> 1) | ((kk & 4u) << 1); return ((((m >> 5) * 8u + h) * 4u + (d8 >> 1)) * 64u + (d8 & 1u) * 32u + kp) * 8u; }
__host__ __device__ __forceinline__ unsigned vfrag8_off(unsigned m8, unsigned h, unsigned d) { const unsigned k8 = (m8 & 31u) >> 3; return (((((m8 >> 5) * 8u + h) * 2u + (d >> 5)) * 2u + (k8 >> 1)) * 64u + (k8 & 1u) * 32u + (d & 31u)) * 8u; }
__host__ __device__ __forceinline__ unsigned krfrag_off(unsigned m, unsigned part, unsigned hi) { const unsigned kk = m & 31u, kp = (kk & ~12u) | ((kk & 8u) >> 1) | ((kk & 4u) << 1); return (((m >> 5) * 2u + part) * 64u + hi * 32u + kp) * 8u; }
__device__ __forceinline__ int modrow(int pm) { return pm < 16 ? 0 : 1 + ((pm - 16) >> 3); }


__device__ __forceinline__ v4u pack8(const f32x4& a, const f32x4& b) { v4u w; w.x = cvtpk(a.x, a.y); w.y = cvtpk(a.z, a.w); w.z = cvtpk(b.x, b.y); w.w = cvtpk(b.z, b.w); return w; }
__device__ __forceinline__ u32x2 pack4(const f32x4& a) { u32x2 w; w.x = cvtpk(a.x, a.y); w.y = cvtpk(a.z, a.w); return w; }
__device__ __forceinline__ float sum4(const f32x4& a) { return (a.x + a.y) + (a.z + a.w); }
__device__ __forceinline__ float sq4(const f32x4& a) { return (a.x * a.x + a.y * a.y) + (a.z * a.z + a.w * a.w); }
__device__ __forceinline__ float sum16f(const float* p) { const f32x4* q = (const f32x4*)p; return (sum4(q[0]) + sum4(q[1])) + (sum4(q[2]) + sum4(q[3])); }
template <class T> __device__ __forceinline__ T ldg(const void* base, unsigned boff) { return *(const T*)((const char*)base + boff); }
template <class T> __device__ __forceinline__ void stg(void* base, unsigned boff, const T& v) { *(T*)((char*)base + boff) = v; }
__device__ __forceinline__ float sum16b(const void* base, unsigned boff) { return (sum4(ldg<f32x4>(base, boff)) + sum4(ldg<f32x4>(base, boff + 16u))) + (sum4(ldg<f32x4>(base, boff + 32u)) + sum4(ldg<f32x4>(base, boff + 48u))); }
#define EPI_FENCE() do { asm volatile("" ::: "memory"); __builtin_amdgcn_sched_barrier(0); } while (0)


struct RowX  { const unsigned char* ssqx; struct Raw { f32x4 a; };
    __device__ __forceinline__ Raw load(const pg8::Unit& u, int t) const { return Raw{ldg<f32x4>(ssqx, (unsigned)(u.pm * 256 + t) * 16u)}; }
    __device__ __forceinline__ void fin(const Raw& r, LAS float* T, int t) const { T[t] = rsqrtf(sum4(r.a) * (1.0f / 1024.0f) + EPS); } };
struct RowQ  { const unsigned char* ssq1; struct Raw { f32x4 a, b; };
    __device__ __forceinline__ Raw load(const pg8::Unit& u, int t) const { const unsigned o = (unsigned)(u.pm * 256 + t) * 64u; return Raw{ldg<f32x4>(ssq1, o + 32u), ldg<f32x4>(ssq1, o + 48u)}; }
    __device__ __forceinline__ void fin(const Raw& r, LAS float* T, int t) const { T[t] = rsqrtf((sum4(r.a) + sum4(r.b)) * (1.0f / 384.0f) + EPS); } };
struct RowKV { const unsigned char* ssq1; bool use; struct Raw { f32x4 a; };
    __device__ __forceinline__ Raw load(const pg8::Unit& u, int t) const { return Raw{ldg<f32x4>(ssq1, (unsigned)(u.pm * 256 + t) * 64u)}; }
    __device__ __forceinline__ void fin(const Raw& r, LAS float* T, int t) const { T[t] = use ? rsqrtf(sum4(r.a) * (1.0f / 256.0f) + EPS) : 1.0f; } };
struct RowNone { struct Raw {}; __device__ __forceinline__ Raw load(const pg8::Unit&, int) const { return Raw{}; } __device__ __forceinline__ void fin(const Raw&, LAS float*, int) const {} };
struct ColNone { struct Raw {}; __device__ __forceinline__ Raw load(const pg8::Unit&, int) const { return Raw{}; } __device__ __forceinline__ void fin(const Raw&, LAS float*, int) const {} };
struct ColIn {
    const float* bias; const float* g_ckv; const float* g_sgu; const float* g_cq;
    struct Raw { float b, g; bool has; };
    __device__ __forceinline__ Raw load(const pg8::Unit& u, int c) const {
        const int T = u.pn; const bool has = (T == 3) || (T == 4) || (T == 6) || (T == 7 && c < 128);
        const float* gp = (T == 4) ? g_sgu + c : (T == 6) ? g_cq + c : (T == 7) ? g_cq + 256 + (c & 127) : g_ckv + c;
        return Raw{bias[modrow(u.pm) * 2048 + T * 256 + c], *gp, has}; }
    __device__ __forceinline__ void fin(const Raw& r, LAS float* T, int c) const { T[256 + c] = r.b; T[512 + c] = r.has ? r.g : 1.0f; }
};
struct ColRes {
    const float* gate; const float* gnext; const float* scnext;
    struct Raw { float g, n, s; };
    __device__ __forceinline__ Raw load(const pg8::Unit& u, int c) const { const int r = modrow(u.pm), col = u.pn * 256 + c; return Raw{gate[(size_t)r * NMOD + col], gnext[col], scnext[(size_t)r * NMOD + col]}; }
    __device__ __forceinline__ void fin(const Raw& r, LAS float* T, int c) const { T[256 + c] = r.g; T[512 + c] = r.n * (r.s + 1.0f); }
};
struct ColFF {
    const float* bias; const float* cw; const float* cb;
    struct Raw { float b, w0, w1, w2, c; };
    __device__ __forceinline__ Raw load(const pg8::Unit& u, int c) const { const int ch = u.pn * 128 + (c & 127), oc = (c < 128) ? ch : DFF + ch;
        return Raw{bias[(size_t)modrow(u.pm) * NFF + u.pn * 256 + c], cw[oc], cw[NFF + oc], cw[2 * NFF + oc], cb[oc]}; }
    __device__ __forceinline__ void fin(const Raw& r, LAS float* T, int c) const { T[256 + c] = r.b; T[512 + c] = r.w0; T[768 + c] = r.w1; T[1024 + c] = r.w2; T[1280 + c] = r.c; }
};
template <class RowFn, class ColFn> struct NextTab {
    typename RowFn::Raw rr; typename ColFn::Raw cr;
    __device__ __forceinline__ void load(const RowFn& rf, const ColFn& cf, const pg8::Unit& u, int t) { rr = rf.load(u, t & 255); cr = cf.load(u, t & 255); }
    __device__ __forceinline__ void store(const RowFn& rf, const ColFn& cf, LAS float* T, int t) const { rf.fin(rr, T, t & 255); cf.fin(cr, T, t & 255); }
};
#define EPI_TAB_END(nt, rf, cf, T, t) do { asm volatile("s_waitcnt lgkmcnt(0)\n\ts_barrier" ::: "memory"); (nt).store(rf, cf, T, t); } while (0)
__device__ __forceinline__ void tput4(LAS unsigned char* wscr, int m, const f32x4& v, int fr, int fq) {
    LAS unsigned short* s = (LAS unsigned short*)wscr + fq * 64 + 16 * m + fr;
    s[0] = (unsigned short)(cvtpk(v.x, 0.f) & 0xffffu); s[256] = (unsigned short)(cvtpk(v.y, 0.f) & 0xffffu); s[512] = (unsigned short)(cvtpk(v.z, 0.f) & 0xffffu); s[768] = (unsigned short)(cvtpk(v.w, 0.f) & 0xffffu);
}
template <int MODE = 0>
__device__ __forceinline__ void tflush(LAS unsigned char* wscr, bf16* VT, unsigned pitch, unsigned colbase, unsigned rowbase, int fr, int fq) {
    const unsigned lane = (unsigned)(fq * 16 + fr);
#pragma unroll
    for (int k = 0; k < 2; ++k) { const unsigned c = lane + 64u * k, j = c >> 5, f = (c >> 3) & 3u, ch = c & 7u;
        const v4u d = *(const LAS v4u*)(wscr + ((j * 4u + f) * 64u + 8u * ch) * 2u);
        const unsigned col = colbase + 8u * f + j, m8 = rowbase + 8u * ch;
        stg<v4u>(VT, (MODE == 1 ? vfrag_off(m8, col >> 6, col & 63u) : MODE == 2 ? vfrag8_off(m8, col >> 6, col & 63u) : col * pitch + m8) * 2u, d); }
}
struct EpiIn {
    static constexpr bool PERM = true, AFTER_DRAIN = false;
    int l; unsigned char* ws; float* out; LAS unsigned char* lds;
    RowX rowfn; ColIn colfn;


    template <int T> __device__ __forceinline__ void tile_tr(const f32x4 (&acc)[2][2][4][2], const pg8::Unit& u, int wr, int wc, int fr, int fq, const LAS float* tab) const {
        const int pm = u.pm; const bool ctx = pm < 16;
        const unsigned ct = (unsigned)(wc * 32 + 8 * fq);
        unsigned char* ssq1 = ws + WS_SSQ1;
        bf16* VT = (bf16*)(ws + (T == 2 ? WS_VTNA : WS_VTSGU));
        float* onv = out + OUT_NV + (size_t)(pm * 4 + l) * 65536;
        LAS unsigned char* wscr = lds + LDS_WSCR + (wr * 4 + wc) * 2048;
#pragma unroll
        for (int ai = 0; ai < 2; ++ai) {
            float ssm[4] = {0.f, 0.f, 0.f, 0.f}, rs4[4];
            const unsigned rowbase = (unsigned)(pm * 256 + ai * 128 + wr * 64);
#pragma unroll
            for (int m = 0; m < 4; ++m) rs4[m] = tab[ai * 128 + wr * 64 + m * 16 + fr];
#pragma unroll
            for (int bj = 0; bj < 2; ++bj)
#pragma unroll
                for (int n = 0; n < 2; ++n) {
                    EPI_FENCE();
                    const f32x4 bv = *(const LAS f32x4*)(tab + 256 + bj * 128 + ct + 4 * n), gv = *(const LAS f32x4*)(tab + 512 + bj * 128 + ct + 4 * n);
#pragma unroll
                    for (int m = 0; m < 4; ++m) {
                        f32x4 z = acc[ai][bj][m][n] * rs4[m] + bv;
                        if (T == 2) {
                            if (ctx) stg<f32x4>(onv, (((unsigned)(ai * 128 + wr * 64 + m * 16 + fr)) * 256u + bj * 128u + ct + 4u * n) * 4u, z);
                        } else {
#pragma unroll
                            for (int j = 0; j < 4; ++j) z[j] = gelu_tanh_f(z[j]);
                            ssm[m] += sq4(z);
                            z = z * gv;
                        }
                        tput4(wscr, m, z, fr, fq);
                    }
                    tflush<(T == 2) ? 1 : 0>(wscr, VT, (unsigned)MT, (unsigned)(bj * 128 + wc * 32 + 4 * n), rowbase, fr, fq);
                }
            if (T == 4) {
#pragma unroll
                for (int m = 0; m < 4; ++m) { float ss = xsum16(ssm[m]); ss = xsum32(ss); if (fq == 0) stg<float>(ssq1, ((rowbase + (unsigned)(m * 16 + fr)) * 16u + 4u + (unsigned)wc) * 4u, ss); }
            }
        }
    }
    template <int T> __device__ __forceinline__ void tile(const f32x4 (&acc)[2][2][4][2], const pg8::Unit& u, int wr, int wc, int fr, int fq, const LAS float* tab) const {
        const int pm = u.pm; const bool ctx = pm < 16;
        const unsigned ct = (unsigned)(wc * 32 + 8 * fq);
        const unsigned char* rope = ws + WS_ROPE;
        unsigned char* ssq1 = ws + WS_SSQ1;
        unsigned char* QNA = ws + WS_QNA; unsigned char* KNA = ws + WS_KNA; unsigned char* CKV = ws + WS_CKV; unsigned char* U = ws + WS_U; unsigned char* CQ = ws + WS_CQ; unsigned char* KR = ws + WS_KR;
        float* o_nk = out + OUT_NK + (size_t)(pm * 4 + l) * 65536; float* o_ckv = out + OUT_CKV + (size_t)(pm * 4 + l) * 65536; float* o_kr = out + OUT_KR + (size_t)(pm * 4 + l) * 8192;
#pragma unroll
        for (int ai = 0; ai < 2; ++ai)
#pragma unroll
            for (int m = 0; m < 4; ++m) {
                const unsigned row_t = (unsigned)(ai * 128 + wr * 64 + m * 16 + fr), row = (unsigned)pm * 256u + row_t;
                EPI_FENCE();
                f32x4 bv[2][2], gv[2][2];
#pragma unroll
                for (int bj = 0; bj < 2; ++bj)
#pragma unroll
                    for (int n = 0; n < 2; ++n) { bv[bj][n] = *(const LAS f32x4*)(tab + 256 + bj * 128 + ct + 4 * n); gv[bj][n] = *(const LAS f32x4*)(tab + 512 + bj * 128 + ct + 4 * n); }
                const float rstd = tab[row_t];
                f32x4 z[2][2];
#pragma unroll
                for (int bj = 0; bj < 2; ++bj)
#pragma unroll
                    for (int n = 0; n < 2; ++n) z[bj][n] = acc[ai][bj][m][n] * rstd + bv[bj][n];
                if (T == 0) {
#pragma unroll
                    for (int bj = 0; bj < 2; ++bj) stg<v4u>(QNA, (row * 256u + bj * 128u + ct) * 2u, pack8(z[bj][0] * QS_NA, z[bj][1] * QS_NA));
                } else if (T == 1) {
#pragma unroll
                    for (int bj = 0; bj < 2; ++bj) {
                        { const unsigned cc = bj * 128u + ct; stg<v4u>(KNA, kfrag_off(row, cc >> 6, (cc & 63u) >> 3) * 2u, pack8(z[bj][0], z[bj][1])); }
                        if (ctx) { const unsigned o = (row_t * 256u + bj * 128u + ct) * 4u; stg<f32x4>(o_nk, o, z[bj][0]); stg<f32x4>(o_nk, o + 16u, z[bj][1]); }
                    }
                } else if (T == 3) {
                    float ss = (sq4(z[0][0]) + sq4(z[0][1])) + (sq4(z[1][0]) + sq4(z[1][1]));
                    ss = xsum16(ss); ss = xsum32(ss);
                    if (fq == 0) stg<float>(ssq1, (row * 16u + 0u + (unsigned)wc) * 4u, ss);
#pragma unroll
                    for (int bj = 0; bj < 2; ++bj) {
                        const f32x4 v0 = z[bj][0] * gv[bj][0], v1 = z[bj][1] * gv[bj][1];
                        stg<v4u>(CKV, (row * 256u + bj * 128u + ct) * 2u, pack8(v0, v1));
                        if (ctx) { const unsigned o = (row_t * 256u + bj * 128u + ct) * 4u; stg<f32x4>(o_ckv, o, v0); stg<f32x4>(o_ckv, o + 16u, v1); }
                    }
                } else if (T == 5) {
#pragma unroll
                    for (int bj = 0; bj < 2; ++bj) {
#pragma unroll
                        for (int n = 0; n < 2; ++n)
#pragma unroll
                            for (int j = 0; j < 4; ++j) z[bj][n][j] = gelu_tanh_f(z[bj][n][j]);
                        stg<v4u>(U, (row * 256u + bj * 128u + ct) * 2u, pack8(z[bj][0], z[bj][1]));
                    }
                } else if (T == 6) {
                    float ss = (sq4(z[0][0]) + sq4(z[0][1])) + (sq4(z[1][0]) + sq4(z[1][1]));
                    ss = xsum16(ss); ss = xsum32(ss);
                    if (fq == 0) stg<float>(ssq1, (row * 16u + 8u + (unsigned)wc) * 4u, ss);
#pragma unroll
                    for (int bj = 0; bj < 2; ++bj) stg<v4u>(CQ, (row * 384u + bj * 128u + ct) * 2u, pack8(z[bj][0] * gv[bj][0], z[bj][1] * gv[bj][1]));
                } else {
                    float ss = sq4(z[0][0]) + sq4(z[0][1]);
                    ss = xsum16(ss); ss = xsum32(ss);
                    if (fq == 0) stg<float>(ssq1, (row * 16u + 12u + (unsigned)wc) * 4u, ss);
                    stg<v4u>(CQ, (row * 384u + 256u + ct) * 2u, pack8(z[0][0] * gv[0][0], z[0][1] * gv[0][1]));
                    if (wc == 0) {
                        const unsigned part = (unsigned)fq >> 1, i0 = 4u * ((unsigned)fq & 1u);
                        f32x4 x1 = z[1][0], x2 = z[1][1];
                        if (ctx) {
                            const unsigned o = (row_t * 32u + part * 16u + i0) * 4u;
                            stg<f32x4>(o_kr, o, x1); stg<f32x4>(o_kr, o + 32u, x2);
                        } else {
                            const unsigned t = (unsigned)((pm - 16) & 7) * 256u + row_t; const unsigned pos = part ? (t & 63u) : (t >> 6);
                            const f32x4 cs0 = ldg<f32x4>(rope, (pos * 8u + i0) * 8u), cs1 = ldg<f32x4>(rope, (pos * 8u + i0) * 8u + 16u);
                            const f32x4 c = {cs0.x, cs0.z, cs1.x, cs1.z}, s = {cs0.y, cs0.w, cs1.y, cs1.w};
                            const f32x4 o1 = x1 * c - x2 * s, o2 = x1 * s + x2 * c; x1 = o1; x2 = o2;
                        }
                        if (ctx) { unsigned char* KRF = ws + WS_KRF; stg<u32x2>(KRF, (krfrag_off(row, part, 0u) + i0) * 2u, pack4(x1)); stg<u32x2>(KRF, (krfrag_off(row, part, 1u) + i0) * 2u, pack4(x2)); }
                        else { stg<u32x2>(KR, (row * 32u + part * 16u + i0) * 2u, pack4(x1)); stg<u32x2>(KR, (row * 32u + part * 16u + 8u + i0) * 2u, pack4(x2)); }
                    }
                }
            }
    }
#ifndef TMASK
#define TMASK 0xFF
#endif
    __device__ __forceinline__ void prefill(const pg8::Unit& u, int wr, int wc, int fr, int fq) const { const int t = (wr * 4 + wc) * 64 + fq * 16 + fr; NextTab<RowX, ColIn> nt; nt.load(rowfn, colfn, u, t); nt.store(rowfn, colfn, (LAS float*)(lds + LDS_TAB), t); }
    __device__ __forceinline__ void operator()(const f32x4 (&acc)[2][2][4][2], const pg8::Unit& u, int wr, int wc, int fr, int fq, int, const pg8::Unit& nxt) const {
        LAS float* tab = (LAS float*)(lds + LDS_TAB); const int t = (wr * 4 + wc) * 64 + fq * 16 + fr;
        NextTab<RowX, ColIn> nt; nt.load(rowfn, colfn, nxt, t);
        switch (u.pn) {
            case 0: if (TMASK & 1) tile<0>(acc, u, wr, wc, fr, fq, tab); break;
            case 1: if (TMASK & 2) tile<1>(acc, u, wr, wc, fr, fq, tab); break;
            case 2: if (TMASK & 4) tile_tr<2>(acc, u, wr, wc, fr, fq, tab); break;
            case 3: if (TMASK & 8) tile<3>(acc, u, wr, wc, fr, fq, tab); break;
            case 4: if (TMASK & 16) tile_tr<4>(acc, u, wr, wc, fr, fq, tab); break;
            case 5: if (TMASK & 32) tile<5>(acc, u, wr, wc, fr, fq, tab); break;
            case 6: if (TMASK & 64) tile<6>(acc, u, wr, wc, fr, fq, tab); break;
            default: if (TMASK & 128) tile<7>(acc, u, wr, wc, fr, fq, tab); break;
        }
        EPI_TAB_END(nt, rowfn, colfn, tab, t);
    }
};

struct EpiQ {
    static constexpr bool PERM = true, AFTER_DRAIN = false;
    unsigned char* ws; LAS unsigned char* lds; RowQ rowfn;
    __device__ __forceinline__ void prefill(const pg8::Unit& u, int wr, int wc, int fr, int fq) const { const int t = (wr * 4 + wc) * 64 + fq * 16 + fr; NextTab<RowQ, ColNone> nt; nt.load(rowfn, ColNone(), u, t); nt.store(rowfn, ColNone(), (LAS float*)(lds + LDS_TAB), t); }
    __device__ __forceinline__ void operator()(const f32x4 (&acc)[2][2][4][2], const pg8::Unit& u, int wr, int wc, int fr, int fq, int, const pg8::Unit& nxt) const {
        const int pm = u.pm, pn = u.pn; const bool ctx = pm < 16; const unsigned ct = (unsigned)(wc * 32 + 8 * fq);
        LAS float* tab = (LAS float*)(lds + LDS_TAB); const int t = (wr * 4 + wc) * 64 + fq * 16 + fr;
        NextTab<RowQ, ColNone> nt; nt.load(rowfn, ColNone(), nxt, t); const unsigned char* rope = ws + WS_ROPE; unsigned char* QMLA = ws + WS_QMLA;
#pragma unroll
        for (int ai = 0; ai < 2; ++ai)
#pragma unroll
            for (int m = 0; m < 4; ++m) {
                const unsigned row_t = (unsigned)(ai * 128 + wr * 64 + m * 16 + fr), row = (unsigned)pm * 256u + row_t;
                EPI_FENCE();
                const float rs = tab[row_t] * QS_MLA;
                if (pn < 2) {
#pragma unroll
                    for (int bj = 0; bj < 2; ++bj) { const unsigned cc = (unsigned)(pn * 256 + bj * 128) + ct, h = cc >> 6, d = cc & 63u;
                        stg<v4u>(QMLA, (row * 768u + h * 96u + d) * 2u, pack8(acc[ai][bj][m][0] * rs, acc[ai][bj][m][1] * rs)); }
                } else {
                    const unsigned part = (unsigned)fq >> 1, i0 = 4u * ((unsigned)fq & 1u);
                    f32x4 c = {1.f, 1.f, 1.f, 1.f}, s = {0.f, 0.f, 0.f, 0.f};
                    if (!ctx) { const unsigned t = (unsigned)((pm - 16) & 7) * 256u + row_t; const unsigned pos = part ? (t & 63u) : (t >> 6);
                        const f32x4 cs0 = ldg<f32x4>(rope, (pos * 8u + i0) * 8u), cs1 = ldg<f32x4>(rope, (pos * 8u + i0) * 8u + 16u);
                        c = (f32x4){cs0.x, cs0.z, cs1.x, cs1.z}; s = (f32x4){cs0.y, cs0.w, cs1.y, cs1.w}; }
#pragma unroll
                    for (int bj = 0; bj < 2; ++bj) { const unsigned h = (unsigned)(bj * 4 + wc);
                        const f32x4 x1 = acc[ai][bj][m][0] * rs, x2 = acc[ai][bj][m][1] * rs;
                        const f32x4 o1 = x1 * c - x2 * s, o2 = x1 * s + x2 * c;
                        const unsigned dst = (row * 768u + h * 96u + 64u + part * 16u + i0) * 2u;
                        stg<u32x2>(QMLA, dst, pack4(o1)); stg<u32x2>(QMLA, dst + 16u, pack4(o2)); }
                }
            }
        EPI_TAB_END(nt, rowfn, ColNone(), tab, t);
    }
};

struct EpiKV {
    static constexpr bool PERM = true, AFTER_DRAIN = false;
    bf16* K; bf16* VT; int vtpitch; LAS unsigned char* lds; RowKV rowfn; bf16* KF; bf16* VF;
    __device__ __forceinline__ void prefill(const pg8::Unit& u, int wr, int wc, int fr, int fq) const { const int t = (wr * 4 + wc) * 64 + fq * 16 + fr; NextTab<RowKV, ColNone> nt; nt.load(rowfn, ColNone(), u, t); nt.store(rowfn, ColNone(), (LAS float*)(lds + LDS_TAB), t); }
    __device__ __forceinline__ void operator()(const f32x4 (&acc)[2][2][4][2], const pg8::Unit& u, int wr, int wc, int fr, int fq, int, const pg8::Unit& nxt) const {
        const int pm = u.pm, pn = u.pn; const unsigned ct = (unsigned)(wc * 32 + 8 * fq);
        LAS unsigned char* wscr = lds + LDS_WSCR + (wr * 4 + wc) * 2048;
        LAS float* tab = (LAS float*)(lds + LDS_TAB); const int t = (wr * 4 + wc) * 64 + fq * 16 + fr;
        NextTab<RowKV, ColNone> nt; nt.load(rowfn, ColNone(), nxt, t);
#pragma unroll
        for (int ai = 0; ai < 2; ++ai) {
            float rs[4];
#pragma unroll
            for (int m = 0; m < 4; ++m) rs[m] = tab[ai * 128 + wr * 64 + m * 16 + fr];
            if (pn < 2) {
#pragma unroll
                for (int m = 0; m < 4; ++m) {
                    const unsigned row = (unsigned)(pm * 256 + ai * 128 + wr * 64 + m * 16 + fr);
                    EPI_FENCE();
#pragma unroll
                    for (int bj = 0; bj < 2; ++bj) { const unsigned cc = (unsigned)(pn * 256 + bj * 128) + ct; const v4u w = pack8(acc[ai][bj][m][0] * rs[m], acc[ai][bj][m][1] * rs[m]);
                        if (KF && pm < 16) stg<v4u>(KF, kfrag8_off(row, cc >> 6, (cc & 63u) >> 3) * 2u, w); else stg<v4u>(K, (row * 512u + cc) * 2u, w); }
                }
            } else {
                const unsigned rowbase = (unsigned)(pm * 256 + ai * 128 + wr * 64);
#pragma unroll
                for (int bj = 0; bj < 2; ++bj)
#pragma unroll
                    for (int n = 0; n < 2; ++n) {
                        EPI_FENCE();
#pragma unroll
                        for (int m = 0; m < 4; ++m) tput4(wscr, m, acc[ai][bj][m][n] * rs[m], fr, fq);
                        if (VF && pm < 16) tflush<2>(wscr, VF, 0u, (unsigned)((pn - 2) * 256 + bj * 128 + wc * 32 + 4 * n), rowbase, fr, fq);
                        else tflush<0>(wscr, VT, (unsigned)vtpitch, (unsigned)((pn - 2) * 256 + bj * 128 + wc * 32 + 4 * n), rowbase, fr, fq);
                    }
            }
        }
        EPI_TAB_END(nt, rowfn, ColNone(), tab, t);
    }
};

template <bool PART>
struct EpiRes {
    static constexpr bool PERM = true, AFTER_DRAIN = false;
    bf16* xr; bf16* XA; float* ssqx; LAS unsigned char* lds; ColRes colfn; const float* pslot; unsigned* pflag;
    __device__ __forceinline__ void prefill(const pg8::Unit& u, int wr, int wc, int fr, int fq) const { const int t = (wr * 4 + wc) * 64 + fq * 16 + fr; NextTab<RowNone, ColRes> nt; nt.load(RowNone(), colfn, u, t); nt.store(RowNone(), colfn, (LAS float*)(lds + LDS_TAB), t); }
    __device__ __forceinline__ void operator()(const f32x4 (&acc)[2][2][4][2], const pg8::Unit& u, int wr, int wc, int fr, int fq, int, const pg8::Unit& nxt) const {
        const int pm = u.pm, pn = u.pn; const unsigned ct = (unsigned)(pn * 256 + wc * 32 + 8 * fq);
        LAS float* tab = (LAS float*)(lds + LDS_TAB); const int t = (wr * 4 + wc) * 64 + fq * 16 + fr;
        NextTab<RowNone, ColRes> nt; nt.load(RowNone(), colfn, nxt, t);
        const unsigned cl = (unsigned)(wc * 32 + 8 * fq);
        __amdgpu_buffer_rsrc_t prs = __builtin_amdgcn_make_buffer_rsrc((void*)(PART ? (const void*)pslot : (const void*)xr), 0, 131072, 0x00020000); const unsigned po = (unsigned)t * 16u;
        if constexpr (PART) {
            if (t == 0) { unsigned sp = 0; while (__hip_atomic_load(pflag, __ATOMIC_RELAXED, __HIP_MEMORY_SCOPE_AGENT) == 0u) { __builtin_amdgcn_s_sleep(1); if (++sp > (1u << 22)) break; } asm volatile("s_waitcnt vmcnt(0)" ::: "memory"); }
            __builtin_amdgcn_s_barrier();
        }
        LAS float* SS = (LAS float*)(lds + LDS_WSCR);
#pragma unroll
        for (int ai = 0; ai < 2; ++ai) {
            EPI_FENCE();
            v4u xb[4][2];
#pragma unroll
            for (int m = 0; m < 4; ++m)
#pragma unroll
                for (int bj = 0; bj < 2; ++bj) xb[m][bj] = ldg<v4u>(xr, ((unsigned)(pm * 256 + ai * 128 + wr * 64 + m * 16 + fr) * (unsigned)DM + ct + bj * 128u) * 2u);
            pg8::sk_u64x2 pb[4][2];
            if constexpr (PART) {
#pragma unroll
                for (int m = 0; m < 4; ++m)
#pragma unroll
                    for (int bj = 0; bj < 2; ++bj) pb[m][bj] = __builtin_bit_cast(pg8::sk_u64x2, __builtin_amdgcn_raw_buffer_load_b128(prs, po + (unsigned)((ai * 2 + bj) * 4 + m) * 8192u, 0,   16));
            }
#pragma unroll
            for (int m = 0; m < 4; ++m) {
                const unsigned row = (unsigned)(pm * 256 + ai * 128 + wr * 64 + m * 16 + fr);
                float ss = 0.f;
#pragma unroll
                for (int bj = 0; bj < 2; ++bj) {
                    EPI_FENCE();
                    const unsigned col = ct + bj * 128u, o = (row * (unsigned)DM + col) * 2u;
                    const f32x4 g0 = *(const LAS f32x4*)(tab + 256 + bj * 128 + cl), g1 = *(const LAS f32x4*)(tab + 256 + bj * 128 + cl + 4);
                    f32x4 a0 = acc[ai][bj][m][0], a1 = acc[ai][bj][m][1];
                    if constexpr (PART) { a0 += pg8::sk_unpack(pb[m][bj].x); a1 += pg8::sk_unpack(pb[m][bj].y); }
                    const v4u xw = xb[m][bj];
                    const f32x4 x0 = (f32x4){hlo(xw.x), hhi(xw.x), hlo(xw.y), hhi(xw.y)} + g0 * a0;
                    const f32x4 x1 = (f32x4){hlo(xw.z), hhi(xw.z), hlo(xw.w), hhi(xw.w)} + g1 * a1;
                    { v4u w; w.x = cvtpkh(x0.x, x0.y); w.y = cvtpkh(x0.z, x0.w); w.z = cvtpkh(x1.x, x1.y); w.w = cvtpkh(x1.z, x1.w); stg<v4u>(xr, o, w); }
                    ss += sq4(x0) + sq4(x1);
                    if (XA) { const f32x4 s0 = *(const LAS f32x4*)(tab + 512 + bj * 128 + cl), s1 = *(const LAS f32x4*)(tab + 512 + bj * 128 + cl + 4);
                        stg<v4u>(XA, o, pack8(x0 * s0, x1 * s1)); }
                }
                ss = xsum16(ss); ss = xsum32(ss);
                if (fq == 0) SS[wc * 256 + ai * 128 + wr * 64 + m * 16 + fr] = ss;
            }
        }
        EPI_TAB_END(nt, RowNone(), colfn, tab, t);
        if (t < 256) stg<float>(ssqx, ((unsigned)(pm * 256 + t) * 4u + (unsigned)pn) * 4u, (SS[t] + SS[256 + t]) + (SS[512 + t] + SS[768 + t]));
    }
};

template <int CTRL> __device__ __forceinline__ f32x4 dpp4(const f32x4& v) { return (f32x4){dpp_f<CTRL>(v.x), dpp_f<CTRL>(v.y), dpp_f<CTRL>(v.z), dpp_f<CTRL>(v.w)}; }
template <int CTRL> __device__ __forceinline__ f32x4 dppk4(const f32x4& old, const f32x4& v) { return (f32x4){dpp_keep_f<CTRL>(old.x, v.x), dpp_keep_f<CTRL>(old.y, v.y), dpp_keep_f<CTRL>(old.z, v.z), dpp_keep_f<CTRL>(old.w, v.w)}; }
__device__ __forceinline__ f32x4 sel4(bool c, const f32x4& a, const f32x4& b) { return (f32x4){c ? a.x : b.x, c ? a.y : b.y, c ? a.z : b.z, c ? a.w : b.w}; }
struct EpiFF1 {
    static constexpr bool PERM = true, AFTER_DRAIN = false;
    bf16* ACT; float* EDGE_A; float* EDGE_P; LAS unsigned char* lds; RowX rowfn; ColFF colfn;
    __device__ __forceinline__ void prefill(const pg8::Unit& u, int wr, int wc, int fr, int fq) const { const int t = (wr * 4 + wc) * 64 + fq * 16 + fr; NextTab<RowX, ColFF> nt; nt.load(rowfn, colfn, u, t); nt.store(rowfn, colfn, (LAS float*)(lds + LDS_TAB), t); }
    __device__ __forceinline__ void operator()(f32x4 (&acc)[2][2][4][2], const pg8::Unit& u, int wr, int wc, int fr, int fq, int, const pg8::Unit& nxt) const {
        const int pm = u.pm, pn = u.pn; const int wave = wr * 4 + wc; const unsigned cl = (unsigned)(wc * 32 + 8 * fq);
        LAS float* T = (LAS float*)(lds + LDS_TAB);
        LAS float* XB = (LAS float*)(lds + LDS_WSCR);
        const int t = wave * 64 + fq * 16 + fr;
        NextTab<RowX, ColFF> nt; nt.load(rowfn, colfn, nxt, t);
#pragma unroll
        for (int ai = 0; ai < 2; ++ai)
#pragma unroll
            for (int m = 0; m < 4; ++m) { const float rs = T[ai * 128 + wr * 64 + m * 16 + fr];
#pragma unroll
                for (int bj = 0; bj < 2; ++bj)
#pragma unroll
                    for (int n = 0; n < 2; ++n) acc[ai][bj][m][n] = acc[ai][bj][m][n] * rs + *(const LAS f32x4*)(T + 256 + bj * 128 + cl + 4 * n); }
#pragma unroll
        for (int ai = 0; ai < 2; ++ai)
#pragma unroll
            for (int bj = 0; bj < 2; ++bj)
#pragma unroll
                for (int n = 0; n < 2; ++n) {
                    if (fr == 0) *(LAS f32x4*)(XB + ((wave * 2 + ai) * 2 + 0) * 64 + fq * 16 + bj * 8 + n * 4) = acc[ai][bj][0][n];
                    if (fr == 15) *(LAS f32x4*)(XB + ((wave * 2 + ai) * 2 + 1) * 64 + fq * 16 + bj * 8 + n * 4) = acc[ai][bj][3][n];
                }
        if (wr == 0 && fr == 0) {
#pragma unroll
            for (int bj = 0; bj < 2; ++bj)
#pragma unroll
                for (int n = 0; n < 2; ++n) stg<f32x4>(EDGE_A, (((unsigned)pm * 2u + 0u) * (unsigned)NFF + (unsigned)(pn * 256 + bj * 128) + cl + 4u * n) * 4u, acc[0][bj][0][n]);
        }
        if (wr == 1 && fr == 15) {
#pragma unroll
            for (int bj = 0; bj < 2; ++bj)
#pragma unroll
                for (int n = 0; n < 2; ++n) stg<f32x4>(EDGE_A, (((unsigned)pm * 2u + 1u) * (unsigned)NFF + (unsigned)(pn * 256 + bj * 128) + cl + 4u * n) * 4u, acc[1][bj][3][n]);
        }
        asm volatile("s_waitcnt lgkmcnt(0)\n\ts_barrier" ::: "memory");
        const int pw = wave ^ 4;
        const f32x4 zero4 = {0.f, 0.f, 0.f, 0.f};
#pragma unroll
        for (int ai = 0; ai < 2; ++ai)
#pragma unroll
            for (int n = 0; n < 2; ++n) {
                EPI_FENCE();
                f32x4 hu[2], hd[2];
#pragma unroll
                for (int bj = 0; bj < 2; ++bj) {
                    const int o = fq * 16 + bj * 8 + n * 4;
                    if (wr == 0) { hu[bj] = (ai == 0) ? zero4 : *(const LAS f32x4*)(XB + ((pw * 2 + 0) * 2 + 1) * 64 + o); hd[bj] = *(const LAS f32x4*)(XB + ((pw * 2 + ai) * 2 + 0) * 64 + o); }
                    else { hu[bj] = *(const LAS f32x4*)(XB + ((pw * 2 + ai) * 2 + 1) * 64 + o); hd[bj] = (ai == 1) ? zero4 : *(const LAS f32x4*)(XB + ((pw * 2 + 1) * 2 + 0) * 64 + o); }
                }
#pragma unroll
                for (int m = 0; m < 4; ++m) {
                    const unsigned row_t = (unsigned)(ai * 128 + wr * 64 + m * 16 + fr), row = (unsigned)(pm * 256) + row_t;
                    f32x4 cv[2];
#pragma unroll
                    for (int bj = 0; bj < 2; ++bj) {
                        const f32x4 X = acc[ai][bj][m][n];
                        const f32x4 upn = (m > 0) ? dpp4<0x121>(acc[ai][bj][m > 0 ? m - 1 : 0][n]) : hu[bj];
                        const f32x4 dnn = (m < 3) ? dpp4<0x12F>(acc[ai][bj][m < 3 ? m + 1 : 3][n]) : hd[bj];
                        const f32x4 up = dppk4<0x111>(upn, X), dn = dppk4<0x101>(dnn, X);
                        const int c = bj * 128 + (int)cl + 4 * n;
                        cv[bj] = *(const LAS f32x4*)(T + 512 + c) * up + *(const LAS f32x4*)(T + 768 + c) * X + *(const LAS f32x4*)(T + 1024 + c) * dn + *(const LAS f32x4*)(T + 1280 + c);
                    }
                    if ((ai == 0 && m == 0 && wr == 0 && fr == 0) || (ai == 1 && m == 3 && wr == 1 && fr == 15)) {
                        const unsigned e = (row_t == 0u) ? 0u : 1u;
#pragma unroll
                        for (int bj = 0; bj < 2; ++bj) stg<f32x4>(EDGE_P, (((unsigned)pm * 2u + e) * (unsigned)NFF + (unsigned)(pn * 256 + bj * 128) + cl + 4u * n) * 4u, cv[bj]);
                    }
                    const f32x4 o = {silu_f(cv[0].x) * cv[1].x, silu_f(cv[0].y) * cv[1].y, silu_f(cv[0].z) * cv[1].z, silu_f(cv[0].w) * cv[1].w};
                    stg<u32x2>(ACT, (row * (unsigned)DFF + (unsigned)(pn * 128) + cl + 4u * n) * 2u, pack4(o));
                }
            }
        EPI_TAB_END(nt, rowfn, colfn, T, t);
    }
};
__device__ __forceinline__ void conv_fixup(int pm, bf16* ACT, const float* EDGE_A, const float* EDGE_P, const float* cw, int tid) {
    if (pm < 16) return;
    const int kq = (pm - 16) & 7;
    for (int ch = tid; ch < DFF; ch += NTHR) {
        const int gi = (ch >> 7) * 256 + (ch & 127), vi = gi + 128;
        if (kq > 0) { const float* P = EDGE_P + (size_t)(pm * 2 + 0) * NFF; const float* A = EDGE_A + (size_t)((pm - 1) * 2 + 1) * NFF;
            const float g = P[gi] + cw[ch] * A[gi], v = P[vi] + cw[DFF + ch] * A[vi];
            ACT[(size_t)(pm * 256) * DFF + ch] = (bf16)(cvtpk(silu_f(g) * v, 0.f) & 0xffffu); }
        if (kq < 7) { const float* P = EDGE_P + (size_t)(pm * 2 + 1) * NFF; const float* A = EDGE_A + (size_t)((pm + 1) * 2 + 0) * NFF;
            const float g = P[gi] + cw[2 * NFF + ch] * A[gi], v = P[vi] + cw[2 * NFF + DFF + ch] * A[vi];
            ACT[(size_t)(pm * 256 + 255) * DFF + ch] = (bf16)(cvtpk(silu_f(g) * v, 0.f) & 0xffffu); }
    }
}


__device__ __forceinline__ f32x16 mfma32(bf16x8 a, bf16x8 b, f32x16 c) { return __builtin_amdgcn_mfma_f32_32x32x16_bf16(a, b, c, 0, 0, 0); }
__device__ __forceinline__ bf16x8 ld8(const bf16* p) { return *(const bf16x8*)p; }

struct NoMod { __device__ __forceinline__ void operator()(f32x16&) const {} };
struct NaMod {
    const LAS float* rpb; int c, cs, kc0; bool en;
    __device__ __forceinline__ void operator()(f32x16& S) const {
        if (!en) return;
#pragma unroll
        for (int s = 0; s < 2; ++s)
#pragma unroll
            for (int j = 0; j < 8; ++j) { const int kc = kc0 + 16 * s + j; const bool ok = (unsigned)(kc - cs) < 16u;
                int co = kc - c; co = co < -15 ? -15 : (co > 15 ? 15 : co);
                const float b = rpb[co + 15];
                S[8 * s + j] = ok ? S[8 * s + j] + b : NEG_BIG; }
    }
};

template <int DK> struct KVF { bf16x8 kf[DK / 16]; bf16x8 vf[2][2]; };
template <int DK>
__device__ __forceinline__ void kv_load(KVF<DK>& f, const bf16* Krow, const bf16* KRrow, const bf16* VTp, size_t vtpitch) {
#pragma unroll
    for (int d0 = 0; d0 < 4; ++d0) f.kf[d0] = ld8(Krow + 16 * d0);
    if constexpr (DK == 96) { f.kf[4] = ld8(KRrow); f.kf[5] = ld8(KRrow + 16); }
#pragma unroll
    for (int blk = 0; blk < 2; ++blk)
#pragma unroll
        for (int s = 0; s < 2; ++s) f.vf[blk][s] = ld8(VTp + (size_t)(32 * blk) * vtpitch + 16 * s);
}
struct CZero { __device__ __forceinline__ void operator()(f32x16& S) const {
#pragma unroll
    for (int i = 0; i < 16; ++i) S[i] = 0.f; } };
struct CBias { f32x4 b[4];
    __device__ __forceinline__ void operator()(f32x16& S) const {
#pragma unroll
        for (int i = 0; i < 4; ++i) { S[i] = b[0][i]; S[4 + i] = b[1][i]; S[8 + i] = b[2][i]; S[12 + i] = b[3][i]; } } };
__device__ __forceinline__ void kv_load_frag(KVF<64>& f, const bf16* Kblk, const bf16* Vblk, int lane) {
#pragma unroll
    for (int d0 = 0; d0 < 4; ++d0) f.kf[d0] = ld8(Kblk + d0 * 512 + lane * 8);
#pragma unroll
    for (int blk = 0; blk < 2; ++blk)
#pragma unroll
        for (int s = 0; s < 2; ++s) f.vf[blk][s] = ld8(Vblk + (blk * 2 + s) * 512 + lane * 8);
}
template <int DK, class Mod, class CInit = CZero>
__device__ __forceinline__ void attn_compute(const KVF<DK>& f, const bf16x8 (&q)[DK / 16], f32x16 (&o)[2], float& m, float& l, const Mod& mod, const CInit& ci = CInit()) {
    f32x16 S;
    ci(S);
#pragma unroll
    for (int d0 = 0; d0 < DK / 16; ++d0) S = mfma32(f.kf[d0], q[d0], S);
    mod(S);
    float mx = S[0];
#pragma unroll
    for (int i = 1; i < 16; ++i) mx = fmaxf(mx, S[i]);
    mx = xmax32(mx);
    if (__any(mx > m)) {
        const float mn = fmaxf(m, mx), alpha = fast_exp2(m - mn); m = mn; l *= alpha;
#pragma unroll
        for (int i = 0; i < 16; ++i) { o[0][i] *= alpha; o[1][i] *= alpha; }
    }
    float ps = 0.f;
#pragma unroll
    for (int i = 0; i < 16; ++i) { S[i] = fast_exp2(S[i] - m); ps += S[i]; }
    l += ps;
    v4u p0, p1;
    p0.x = cvtpk(S[0], S[1]); p0.y = cvtpk(S[2], S[3]); p0.z = cvtpk(S[4], S[5]); p0.w = cvtpk(S[6], S[7]);
    p1.x = cvtpk(S[8], S[9]); p1.y = cvtpk(S[10], S[11]); p1.z = cvtpk(S[12], S[13]); p1.w = cvtpk(S[14], S[15]);
    const bf16x8 pb0 = __builtin_bit_cast(bf16x8, p0), pb1 = __builtin_bit_cast(bf16x8, p1);
    o[0] = mfma32(f.vf[0][0], pb0, o[0]); o[0] = mfma32(f.vf[0][1], pb1, o[0]);
    o[1] = mfma32(f.vf[1][0], pb0, o[1]); o[1] = mfma32(f.vf[1][1], pb1, o[1]);
}
__device__ __forceinline__ void attn_store(const f32x16 (&o)[2], float l, bf16* dst, int hi) {
    const float lt = xsum32(l); const float inv = 1.0f / lt;
#pragma unroll
    for (int blk = 0; blk < 2; ++blk)
#pragma unroll
        for (int g = 0; g < 4; ++g) { const f32x4 v = {o[blk][4 * g] * inv, o[blk][4 * g + 1] * inv, o[blk][4 * g + 2] * inv, o[blk][4 * g + 3] * inv};
            *(u32x2*)(dst + 32 * blk + 8 * g + 4 * hi) = pack4(v); }
}

struct P3Ptrs {
    unsigned char* ws; int l; const float* b_sgu;
    __device__ __forceinline__ const bf16* p(size_t off) const { return (const bf16*)(ws + off); }
};
#define P3_QNA P.p(WS_QNA)
#define P3_KNA P.p(WS_KNA)
#define P3_VTNA P.p(WS_VTNA)
#define P3_KCNA (P.p(WS_KCNA) + (size_t)P.l * 1024 * 256)
#define P3_VTCNA (P.p(WS_VTCNA) + (size_t)P.l * 256 * 1024)
#define P3_QMLA P.p(WS_QMLA)
#define P3_KMLA P.p(WS_KMLA)
#define P3_KR P.p(WS_KR)
#define P3_VTMLA P.p(WS_VTMLA)
#define P3_KCMLA (P.p(WS_KCMLA) + (size_t)P.l * 1024 * 512)
#define P3_KRC (P.p(WS_KRC) + (size_t)P.l * 1024 * 32)
#define P3_VTCMLA (P.p(WS_VTCMLA) + (size_t)P.l * 512 * 1024)
#define P3_U P.p(WS_U)
#define P3_VTSGU P.p(WS_VTSGU)
#define P3_WSGU (P.p(WS_WSGU) + (size_t)P.l * 4 * 128 * 128)
#define P3_RSV ((const float*)(P.ws + WS_RSV))
#define P3_MIX ((bf16*)(P.ws + WS_MIX))

constexpr int MLA_KT_PITCH = 104, MLA_VT_PITCH = 72, MLA_KT_BYTES = 64 * MLA_KT_PITCH * 2, MLA_BUF_BYTES = MLA_KT_BYTES + 64 * MLA_VT_PITCH * 2;
__device__ __forceinline__ void unit_mla_lat_wg(const P3Ptrs& P, int u, int wave, int lane, LAS unsigned char* lds) {
    const int r32 = lane & 31, hi = lane >> 5, kap = (r32 & ~12) | ((r32 & 8) >> 1) | ((r32 & 4) << 1);
    const int qb8 = u & 7, h = (u >> 3) & 7, b = u >> 6;
    const size_t mq = (size_t)NCTX + (size_t)b * 2048 + 256 * qb8 + 32 * wave + r32;
    bf16x8 q[6];
#pragma unroll
    for (int d0 = 0; d0 < 6; ++d0) q[d0] = ld8(P3_QMLA + mq * 768 + h * 96 + 16 * d0 + 8 * hi);
    f32x16 o[2];
#pragma unroll
    for (int i = 0; i < 16; ++i) { o[0][i] = 0.f; o[1][i] = 0.f; }
    float mref = 0.f, l = 0.f; bool first = true;
    f32x16 negm;
#pragma unroll
    for (int i = 0; i < 16; ++i) negm[i] = 0.f;
    const int t = wave * 64 + lane;
    const int kkey = t >> 3, kc = t & 7, rkey = (t & 255) >> 2, rc = t & 3;
    const unsigned wK = (unsigned)(kkey * MLA_KT_PITCH + 8 * kc) * 2u, wR = (unsigned)(rkey * MLA_KT_PITCH + 64 + 8 * rc) * 2u, wV = (unsigned)MLA_KT_BYTES + (unsigned)(kkey * MLA_VT_PITCH + 8 * kc) * 2u;
    const unsigned rK = (unsigned)(kap * MLA_KT_PITCH + 8 * hi) * 2u, rV = (unsigned)MLA_KT_BYTES + (unsigned)(r32 * MLA_VT_PITCH + 8 * hi) * 2u;
    const size_t mk = (size_t)NCTX + (size_t)b * 2048;
    const char* KCb = (const char*)(P3_KCMLA + (size_t)(b * 256) * 512 + h * 64);
    const char* RCb = (const char*)(P3_KRC + (size_t)(b * 256) * 32);
    const char* VCb = (const char*)(P3_VTCMLA + (size_t)(h * 64) * 1024 + b * 256);
    const char* KLb = (const char*)(P3_KMLA + mk * 512 + h * 64);
    const char* RLb = (const char*)(P3_KR + mk * 32);
    const char* VLb = (const char*)(P3_VTMLA + (size_t)(h * 64) * MT + mk);
    const unsigned oK = (unsigned)(kkey * 512 + 8 * kc) * 2u, oR = (unsigned)(rkey * 32 + 8 * rc) * 2u, oVc = (unsigned)(kkey * 1024 + 8 * kc) * 2u, oVl = (unsigned)(kkey * MT + 8 * kc) * 2u;
    v4u xk, xr = {0u, 0u, 0u, 0u}, xv, yk, yr = {0u, 0u, 0u, 0u}, yv;
#define MLA_FETCH(gk, gr, gv, tile) do { const bool cx_ = (tile) < 4; const size_t tt_ = cx_ ? (size_t)(tile) : (size_t)((tile) - 4); \
        const char* kb_ = (cx_ ? KCb : KLb) + tt_ * (64 * 512 * 2); const char* rb_ = (cx_ ? RCb : RLb) + tt_ * (64 * 32 * 2); const char* vb_ = (cx_ ? VCb : VLb) + tt_ * (64 * 2); \
        gk = *(const v4u*)(kb_ + oK); gr = *(const v4u*)(rb_ + oR); gv = *(const v4u*)(vb_ + (cx_ ? oVc : oVl)); } while (0)
#define MLA_PUT(gk, gr, gv, buf) do { LAS unsigned char* bp_ = lds + (buf) * MLA_BUF_BYTES; *(LAS v4u*)(bp_ + wK) = gk; *(LAS v4u*)(bp_ + wR) = gr; *(LAS v4u*)(bp_ + wV) = gv; } while (0)
#ifndef MLA_PROBE
#define MLA_PROBE 0
#endif
#if MLA_PROBE == 1
#define MLA_PROBE_VALU() do { float dd_ = 0.f; _Pragma("unroll") for (int i = 0; i < 16; ++i) { dd_ += fast_exp2(S0[i] * 0.5f - mref) + fast_exp2(S1[i] * 0.5f - mref); } asm volatile("" :: "v"(dd_)); } while (0)
#else
#define MLA_PROBE_VALU() do {} while (0)
#endif
#if MLA_PROBE == 2
#define MLA_PROBE_MFMA() do { f32x16 dm_; _Pragma("unroll") for (int i = 0; i < 16; ++i) dm_[i] = 0.f; _Pragma("unroll") for (int d0 = 0; d0 < 4; ++d0) { dm_ = mfma32(kf[0][d0], q[d0 + 1], dm_); dm_ = mfma32(kf[1][d0], q[d0 + 2], dm_); } asm volatile("" :: "v"(dm_)); } while (0)
#else
#define MLA_PROBE_MFMA() do {} while (0)
#endif
#define MLA_TILE(buf) do { \
        const LAS unsigned char* bp = lds + (buf) * MLA_BUF_BYTES; \
        bf16x8 kf[2][6]; \
        _Pragma("unroll") for (int d0 = 0; d0 < 6; ++d0) { kf[0][d0] = *(const LAS bf16x8*)(bp + rK + d0 * 32); kf[1][d0] = *(const LAS bf16x8*)(bp + rK + 32 * MLA_KT_PITCH * 2 + d0 * 32); } \
        __builtin_amdgcn_sched_barrier(0); \
        f32x16 S0 = mfma32(kf[0][0], q[0], negm), S1 = mfma32(kf[1][0], q[0], negm);     \
        _Pragma("unroll") for (int d0 = 1; d0 < 6; ++d0) { S0 = mfma32(kf[0][d0], q[d0], S0); S1 = mfma32(kf[1][d0], q[d0], S1); } \
        bf16x8 vf[2][4]; \
        _Pragma("unroll") for (int blk = 0; blk < 2; ++blk) _Pragma("unroll") for (int s = 0; s < 4; ++s) vf[blk][s] = *(const LAS bf16x8*)(bp + rV + blk * 32 * MLA_VT_PITCH * 2 + s * 32); \
        __builtin_amdgcn_sched_barrier(0); \
        float mx = fmaxf(S0[0], S1[0]); \
        _Pragma("unroll") for (int i = 1; i < 16; ++i) mx = fmaxf(fmaxf(S0[i], S1[i]), mx); \
        mx = xmax32(mx); \
        if (first || __any(mx > 8.0f)) {     \
            const float dl = first ? mx : fmaxf(mx, 0.f), alpha = fast_exp2(-dl); mref += dl; l *= alpha; first = false; \
            _Pragma("unroll") for (int i = 0; i < 16; ++i) { o[0][i] *= alpha; o[1][i] *= alpha; S0[i] -= dl; S1[i] -= dl; negm[i] = -mref; } } \
        float ps = 0.f; \
        _Pragma("unroll") for (int i = 0; i < 16; ++i) { S0[i] = fast_exp2(S0[i]); S1[i] = fast_exp2(S1[i]); ps += S0[i] + S1[i]; } \
        l += ps; \
        MLA_PROBE_VALU(); MLA_PROBE_MFMA(); \
        v4u p0, p1, p2, p3; \
        p0.x = cvtpk(S0[0], S0[1]); p0.y = cvtpk(S0[2], S0[3]); p0.z = cvtpk(S0[4], S0[5]); p0.w = cvtpk(S0[6], S0[7]); \
        p1.x = cvtpk(S0[8], S0[9]); p1.y = cvtpk(S0[10], S0[11]); p1.z = cvtpk(S0[12], S0[13]); p1.w = cvtpk(S0[14], S0[15]); \
        p2.x = cvtpk(S1[0], S1[1]); p2.y = cvtpk(S1[2], S1[3]); p2.z = cvtpk(S1[4], S1[5]); p2.w = cvtpk(S1[6], S1[7]); \
        p3.x = cvtpk(S1[8], S1[9]); p3.y = cvtpk(S1[10], S1[11]); p3.z = cvtpk(S1[12], S1[13]); p3.w = cvtpk(S1[14], S1[15]); \
        const bf16x8 pb0 = __builtin_bit_cast(bf16x8, p0), pb1 = __builtin_bit_cast(bf16x8, p1), pb2 = __builtin_bit_cast(bf16x8, p2), pb3 = __builtin_bit_cast(bf16x8, p3); \
        _Pragma("unroll") for (int blk = 0; blk < 2; ++blk) { o[blk] = mfma32(vf[blk][0], pb0, o[blk]); o[blk] = mfma32(vf[blk][1], pb1, o[blk]); o[blk] = mfma32(vf[blk][2], pb2, o[blk]); o[blk] = mfma32(vf[blk][3], pb3, o[blk]); } \
    } while (0)
    MLA_FETCH(xk, xr, xv, 0); MLA_PUT(xk, xr, xv, 0);
    MLA_FETCH(xk, xr, xv, 1); MLA_FETCH(yk, yr, yv, 2);
    __syncthreads();
#pragma unroll 1
    for (int tile = 0; tile < 36; tile += 2) {
        MLA_TILE(0);
        MLA_PUT(xk, xr, xv, 1);
        MLA_FETCH(xk, xr, xv, tile + 3 < 36 ? tile + 3 : 35);
        __syncthreads();
        MLA_TILE(1);
        if (tile + 2 < 36) MLA_PUT(yk, yr, yv, 0);
        MLA_FETCH(yk, yr, yv, tile + 4 < 36 ? tile + 4 : 35);
        __syncthreads();
    }
#undef MLA_FETCH
#undef MLA_PUT
#undef MLA_TILE
    attn_store(o, l, P3_MIX + mq * 1024 + 256 + h * 64, hi);
}
__device__ __forceinline__ void unit_mla_ctx(const P3Ptrs& P, int u, int lane) {
    const int r32 = lane & 31, hi = lane >> 5, kap = (r32 & ~12) | ((r32 & 8) >> 1) | ((r32 & 4) << 1);
    const int qb = u & 7, h = (u >> 3) & 7, b = u >> 6;
    const size_t mq = (size_t)b * 256 + 32 * qb + r32, mk = (size_t)b * 256;
    bf16x8 q[6];
#pragma unroll
    for (int d0 = 0; d0 < 6; ++d0) q[d0] = ld8(P3_QMLA + mq * 768 + h * 96 + 16 * d0 + 8 * hi);
    f32x16 o[2];
#pragma unroll
    for (int i = 0; i < 16; ++i) { o[0][i] = 0.f; o[1][i] = 0.f; }
    float m = NEG_BIG, l = 0.f;
    const bf16* Kb = P3_KMLA + ((size_t)(mk >> 5) * 8 + h) * 2048 + lane * 8;
    const bf16* Rb = (const bf16*)(P.ws + WS_KRF) + (size_t)(mk >> 5) * 1024 + lane * 8;
    const bf16* Vb = (const bf16*)(P.ws + WS_VFM) + ((size_t)(mk >> 5) * 8 + h) * 2048 + lane * 8;
    KVF<96> A, B, C;
#define CTX_LD(F, t) do { const int tt_ = (t) < 8 ? (t) : 7; const bf16* k_ = Kb + (size_t)tt_ * 16384; const bf16* r_ = Rb + (size_t)tt_ * 1024; const bf16* v_ = Vb + (size_t)tt_ * 16384; \
        F.kf[0] = ld8(k_); F.kf[1] = ld8(k_ + 512); F.kf[2] = ld8(k_ + 1024); F.kf[3] = ld8(k_ + 1536); F.kf[4] = ld8(r_); F.kf[5] = ld8(r_ + 512); \
        F.vf[0][0] = ld8(v_); F.vf[0][1] = ld8(v_ + 512); F.vf[1][0] = ld8(v_ + 1024); F.vf[1][1] = ld8(v_ + 1536); } while (0)
    CTX_LD(A, 0); CTX_LD(B, 1); CTX_LD(C, 2);
#pragma unroll
    for (int t = 0; t < 9; t += 3) {
        attn_compute<96>(A, q, o, m, l, NoMod()); CTX_LD(A, t + 3);
        attn_compute<96>(B, q, o, m, l, NoMod()); CTX_LD(B, t + 4);
        if (t + 2 < 8) { attn_compute<96>(C, q, o, m, l, NoMod()); CTX_LD(C, t + 5); }
    }
#undef CTX_LD
    attn_store(o, l, P3_MIX + mq * 1024 + 256 + h * 64, hi);
}
__device__ __forceinline__ void unit_na_ctx(const P3Ptrs& P, int u, int lane) {
    const int r32 = lane & 31, hi = lane >> 5, kap = (r32 & ~12) | ((r32 & 8) >> 1) | ((r32 & 4) << 1);
    const int qb = u & 7, h = (u >> 3) & 3, b = u >> 5;
    const size_t mq = (size_t)b * 256 + 32 * qb + r32, mk = (size_t)b * 256;
    bf16x8 q[4];
#pragma unroll
    for (int d0 = 0; d0 < 4; ++d0) q[d0] = ld8(P3_QNA + mq * 256 + h * 64 + 16 * d0 + 8 * hi);
    f32x16 o[2];
#pragma unroll
    for (int i = 0; i < 16; ++i) { o[0][i] = 0.f; o[1][i] = 0.f; }
    float m = NEG_BIG, l = 0.f;
    const bf16* Kb = P3_KNA + ((size_t)(mk >> 5) * 4 + h) * 2048;
    const bf16* Vb = P3_VTNA + ((size_t)(mk >> 5) * 4 + h) * 2048;
    KVF<64> A, B, C;
#define CTX_LD(F, t) do { const int tt_ = (t) < 8 ? (t) : 7; kv_load_frag(F, Kb + (size_t)tt_ * 8192, Vb + (size_t)tt_ * 8192, lane); } while (0)
    CTX_LD(A, 0); CTX_LD(B, 1); CTX_LD(C, 2);
#pragma unroll
    for (int t = 0; t < 9; t += 3) {
        attn_compute<64>(A, q, o, m, l, NoMod()); CTX_LD(A, t + 3);
        attn_compute<64>(B, q, o, m, l, NoMod()); CTX_LD(B, t + 4);
        if (t + 2 < 8) { attn_compute<64>(C, q, o, m, l, NoMod()); CTX_LD(C, t + 5); }
    }
#undef CTX_LD
    attn_store(o, l, P3_MIX + mq * 1024 + h * 64, hi);
}
__device__ __forceinline__ void unit_na_lat(const P3Ptrs& P, int u, int lane) {
    const int r32 = lane & 31, hi = lane >> 5, kap = (r32 & ~12) | ((r32 & 8) >> 1) | ((r32 & 4) << 1);
    const int qh = u & 1, gr = (u >> 1) & 31, h = (u >> 6) & 3, b = u >> 8;
    const int c = 32 * qh + r32;
    const size_t mb = (size_t)NCTX + (size_t)b * 2048, mq = mb + gr * 64 + c;
    bf16x8 q[4];
#pragma unroll
    for (int d0 = 0; d0 < 4; ++d0) q[d0] = ld8(P3_QNA + mq * 256 + h * 64 + 16 * d0 + 8 * hi);
    f32x16 o[2];
#pragma unroll
    for (int i = 0; i < 16; ++i) { o[0][i] = 0.f; o[1][i] = 0.f; }
    float m = NEG_BIG, l = 0.f;
    int R0 = gr - 4; R0 = R0 < 0 ? 0 : (R0 > 24 ? 24 : R0);
    const bf16* Kc = P3_KCNA + ((size_t)(b * 8) * 4 + h) * 2048;
    const bf16* Vc = P3_VTCNA + ((size_t)(b * 8) * 4 + h) * 2048;
    const size_t tl0 = ((mb + (size_t)R0 * 64) >> 5);
    const bf16* Kl = P3_KNA + (tl0 * 4 + h) * 2048;
    const bf16* Vl = P3_VTNA + (tl0 * 4 + h) * 2048;
    const float* BT = (const float*)(P.ws + WS_NABT) + (size_t)((P.l * 4 + h) * 16) * 4096 + qh * 2048 + lane * 4;
    const int ro0 = R0 - gr + 7;
#define NA_LOAD(F, Bv, t) do { const int tt_ = (t) < 24 ? (t) : 23; const bool cx_ = tt_ < 8; \
        kv_load_frag(F, cx_ ? Kc + (size_t)tt_ * 8192 : Kl + (size_t)(tt_ - 8) * 8192, cx_ ? Vc + (size_t)tt_ * 8192 : Vl + (size_t)(tt_ - 8) * 8192, lane); \
        const float* bp_ = BT + (size_t)(cx_ ? 15 : ro0 + ((tt_ - 8) >> 1)) * 4096 + (cx_ ? 0 : 1024 * (tt_ & 1)); \
        Bv.b[0] = *(const f32x4*)bp_; Bv.b[1] = *(const f32x4*)(bp_ + 256); Bv.b[2] = *(const f32x4*)(bp_ + 512); Bv.b[3] = *(const f32x4*)(bp_ + 768); } while (0)
    KVF<64> A, B, C; CBias bA, bB, bC;
    NA_LOAD(A, bA, 0); NA_LOAD(B, bB, 1); NA_LOAD(C, bC, 2);
#pragma unroll 1
    for (int t = 0; t < 24; t += 3) {
        attn_compute<64>(A, q, o, m, l, NoMod(), bA); NA_LOAD(A, bA, t + 3);
        attn_compute<64>(B, q, o, m, l, NoMod(), bB); NA_LOAD(B, bB, t + 4);
        attn_compute<64>(C, q, o, m, l, NoMod(), bC); NA_LOAD(C, bC, t + 5);
    }
#undef NA_LOAD
    attn_store(o, l, P3_MIX + mq * 1024 + h * 64, hi);
}
__device__ __forceinline__ void unit_sgu(const P3Ptrs& P, int u, int lane) {
    const int r32 = lane & 31, hi = lane >> 5;
    const int pb = u & 3, g = (u >> 2) & 3, chunk = u >> 4;
    const size_t m0 = (size_t)chunk * 128;
    f32x16 a0, a1;
#pragma unroll
    for (int i = 0; i < 16; ++i) { a0[i] = 0.f; a1[i] = 0.f; }
    const bf16* Wp = P3_WSGU + ((size_t)g * 128 + 32 * pb + r32) * 128 + 8 * hi;
    const bf16* V0 = P3_VTSGU + (size_t)(g * 64 + r32) * MT + m0 + 8 * hi;
    const float* Rp = P3_RSV + m0 + 8 * hi;
#pragma unroll 2
    for (int s = 0; s < 8; ++s) {
        const v4u wr = *(const v4u*)(Wp + 16 * s);
        const f32x4 r0 = *(const f32x4*)(Rp + 16 * s), r1 = *(const f32x4*)(Rp + 16 * s + 4);
        v4u wb; wb.x = cvtpk(bflo(wr.x) * r0.x, bfhi(wr.x) * r0.y); wb.y = cvtpk(bflo(wr.y) * r0.z, bfhi(wr.y) * r0.w);
        wb.z = cvtpk(bflo(wr.z) * r1.x, bfhi(wr.z) * r1.y); wb.w = cvtpk(bflo(wr.w) * r1.z, bfhi(wr.w) * r1.w);
        const bf16x8 bfr = __builtin_bit_cast(bf16x8, wb);
        a0 = mfma32(ld8(V0 + 16 * s), bfr, a0);
        a1 = mfma32(ld8(V0 + (size_t)32 * MT + 16 * s), bfr, a1);
    }
    const float bs = P.b_sgu[g * 128 + 32 * pb + r32];
    const size_t row = m0 + 32 * pb + r32;
#pragma unroll
    for (int blk = 0; blk < 2; ++blk)
#pragma unroll
        for (int gg = 0; gg < 4; ++gg) { const int d0 = g * 64 + 32 * blk + 8 * gg + 4 * hi;
            const u32x2 uu = *(const u32x2*)(P3_U + row * 256 + d0);
            const f32x16& a = blk ? a1 : a0;
            const f32x4 v = {bflo(uu.x) * (a[4 * gg] + bs), bfhi(uu.x) * (a[4 * gg + 1] + bs), bflo(uu.y) * (a[4 * gg + 2] + bs), bfhi(uu.y) * (a[4 * gg + 3] + bs)};
            *(u32x2*)(P3_MIX + row * 1024 + 768 + d0) = pack4(v); }
}


struct DstLin { size_t dpitch; __device__ __forceinline__ size_t operator()(int n, int k) const { return (size_t)n * dpitch + k; } };
struct DstVFrag { __device__ __forceinline__ size_t operator()(int n, int k) const { return vfrag_off((unsigned)k, (unsigned)n >> 6, (unsigned)n & 63u); } };
template <class Map, class Dst>
__device__ __forceinline__ void transpose_item(const float* W, int N, bf16* WT, const Dst& dst, int koff, LAS float* scr, int k0, int n0d, int lane, const Map& map) {
    const int sc = map(n0d + (lane & 31));
    const float msk = sc >= 0 ? 1.f : 0.f; const float* wp = W + (size_t)(k0 + (lane >> 5)) * N + (sc >= 0 ? sc : 0);
    float v[32];
#pragma unroll
    for (int i = 0; i < 32; ++i) v[i] = wp[(size_t)(2 * i) * N];
#pragma unroll
    for (int i = 0; i < 32; ++i) scr[(2 * i + (lane >> 5)) * 33 + (lane & 31)] = v[i] * msk;
    LDS_WAIT(); asm volatile("" ::: "memory");
    const int c = lane & 7;
#pragma unroll
    for (int j = 0; j < 4; ++j) { const int n = (lane >> 3) + 8 * j; const LAS float* s = scr + (8 * c) * 33 + n;
        v4u o; o.x = cvtpk(s[0 * 33], s[1 * 33]); o.y = cvtpk(s[2 * 33], s[3 * 33]); o.z = cvtpk(s[4 * 33], s[5 * 33]); o.w = cvtpk(s[6 * 33], s[7 * 33]);
        *(v4u*)(WT + dst(n0d + n, koff + k0 + 8 * c)) = o; }
    LDS_WAIT(); asm volatile("" ::: "memory");
}
template <class Map>
__device__ __forceinline__ void transpose_item4(const float* W, int N, bf16* WT, size_t dpitch, LAS unsigned char* scr, int k0, int n0d, int lane, const Map& map) {
    const int c4 = lane & 31, kh = lane >> 5;
    const int sc = map(n0d + 4 * c4);
    const float msk = sc >= 0 ? 1.f : 0.f; const float* wp = W + (size_t)(k0 + 32 * kh) * N + (sc >= 0 ? sc : 0);
    f32x4 v[32];
#pragma unroll
    for (int i = 0; i < 32; ++i) v[i] = *(const f32x4*)(wp + (size_t)i * N);
#pragma unroll
    for (int j = 0; j < 4; ++j)
#pragma unroll
        for (int q = 0; q < 4; ++q) { v4u o;
            o.x = cvtpk(v[8 * q + 0][j] * msk, v[8 * q + 1][j] * msk); o.y = cvtpk(v[8 * q + 2][j] * msk, v[8 * q + 3][j] * msk); o.z = cvtpk(v[8 * q + 4][j] * msk, v[8 * q + 5][j] * msk); o.w = cvtpk(v[8 * q + 6][j] * msk, v[8 * q + 7][j] * msk);
            *(LAS v4u*)(scr + (4 * c4 + j) * 128 + (((4 * kh + q) ^ (c4 & 7)) << 4)) = o; }
    LDS_WAIT(); asm volatile("" ::: "memory");
#pragma unroll
    for (int s = 0; s < 16; ++s) { const int p = lane + 64 * s, n = p >> 3, kq = p & 7;
        *(v4u*)(WT + (size_t)(n0d + n) * dpitch + k0 + 8 * kq) = *(const LAS v4u*)(scr + n * 128 + ((kq ^ ((n >> 2) & 7)) << 4)); }
    LDS_WAIT(); asm volatile("" ::: "memory");
}
struct MapId { __device__ __forceinline__ int operator()(int n) const { return n; } };
__device__ __forceinline__ int rope_src(int p) { const int fq = p >> 3, e = p & 7; return (fq >> 1) * 16 + ((e >> 2) << 3) + 4 * (fq & 1) + (e & 3); }
struct MapIn { __device__ __forceinline__ int operator()(int n) const {
    if (n < 768) return n;
    if (n < 1024) return 1152 + (n - 768);
    if (n < 1280) return 1696 + (n - 1024);
    if (n < 1536) return 1440 + (n - 1280);
    if (n < 1920) return 768 + (n - 1536);
    if (n < 1952) return 1408 + rope_src(n - 1920);
    return -1; } };
struct MapUq { __device__ __forceinline__ int operator()(int n) const {
    if (n < 512) return (n >> 6) * 96 + (n & 63);
    const int h = (n - 512) >> 5, p = (n - 512) & 31; return h * 96 + 64 + rope_src(p); } };
struct MapF1 { __device__ __forceinline__ int operator()(int n) const { return (n >> 8) * 128 + (n & 127) + ((n & 128) ? DFF : 0); } };
struct MapUkv { __device__ __forceinline__ int operator()(int n) const {
    if (n < 512) return (n >> 6) * 128 + (n & 63);
    return ((n - 512) >> 6) * 128 + 64 + (n & 63); } };


template <bool CONTIG, class Map>
__device__ __forceinline__ void gemv5_item(const float* W, int N, const Map& map, int n0, const LAS float* S, LAS float* part, const float* badd, float* dst, size_t dstride, int wave, int lane, int tid) {
    const int c0 = map(n0 + 2 * lane), c1 = map(n0 + 2 * lane + 1);
    const float m0 = c0 >= 0 ? 1.f : 0.f, m1 = c1 >= 0 ? 1.f : 0.f; const int i0 = c0 >= 0 ? c0 : 0, i1 = c1 >= 0 ? c1 : 0;
    float a[5][2];
#pragma unroll
    for (int r = 0; r < 5; ++r) { a[r][0] = 0.f; a[r][1] = 0.f; }
    const float* wp = W + (size_t)(wave * 128) * N;
    float wa0[16], wa1[16], wb0[16], wb1[16];
#define GEMV_LOAD(w0_, w1_, kb_) do { _Pragma("unroll") for (int k = 0; k < 16; ++k) { \
        if (CONTIG) { const f32x2 t_ = *(const f32x2*)(wp + (size_t)((kb_) + k) * N + i0); w0_[k] = t_.x; w1_[k] = t_.y; } \
        else { w0_[k] = wp[(size_t)((kb_) + k) * N + i0] * m0; w1_[k] = wp[(size_t)((kb_) + k) * N + i1] * m1; } } } while (0)
#define GEMV_FMA(w0_, w1_, kb_) do { _Pragma("unroll") for (int k = 0; k < 16; ++k) _Pragma("unroll") for (int r = 0; r < 5; ++r) { \
        const float s_ = S[r * 1024 + wave * 128 + (kb_) + k]; a[r][0] += s_ * w0_[k]; a[r][1] += s_ * w1_[k]; } } while (0)
    GEMV_LOAD(wa0, wa1, 0);
#pragma unroll 1
    for (int kb = 0; kb < 128; kb += 32) {
        GEMV_LOAD(wb0, wb1, kb + 16);
        asm volatile("" ::: "memory"); __builtin_amdgcn_sched_barrier(0);
        GEMV_FMA(wa0, wa1, kb);
        asm volatile("" ::: "memory"); __builtin_amdgcn_sched_barrier(0);
        { const int kn = kb + 32 < 128 ? kb + 32 : 0; GEMV_LOAD(wa0, wa1, kn); }
        asm volatile("" ::: "memory"); __builtin_amdgcn_sched_barrier(0);
        GEMV_FMA(wb0, wb1, kb + 16);
    }
#undef GEMV_LOAD
#undef GEMV_FMA
#pragma unroll
    for (int r = 0; r < 5; ++r) { part[(wave * 5 + r) * 128 + 2 * lane] = a[r][0]; part[(wave * 5 + r) * 128 + 2 * lane + 1] = a[r][1]; }
    __syncthreads();
    for (int i = tid; i < 640; i += NTHR) { const int r = i >> 7, cc = i & 127; float s = badd ? badd[n0 + cc] : 0.f;
#pragma unroll
        for (int w = 0; w < 8; ++w) s += part[(w * 5 + r) * 128 + cc];
        dst[(size_t)r * dstride + n0 + cc] = s; }
    __syncthreads();
}
__device__ __forceinline__ void mods_work(const float* c_lat, const float* c_ctx, const float* w_mod, const float* b_mod, float* MODS, LAS unsigned char* lds, int l_lo, int l_hi, int widx, int wcnt, int wave, int lane, int tid) {
    LAS float* sc = (LAS float*)lds;
    LAS float* part = (LAS float*)(lds + 20480);
    for (int i = tid; i < 5 * 1024; i += NTHR) { const int r = i >> 10, k = i & 1023; const float cv = (r == 0) ? c_ctx[k] : c_lat[(r - 1) * 1024 + k]; sc[i] = cv / (1.0f + expf(-cv)); }
    __syncthreads();
    for (int item = widx; item < (l_hi - l_lo) * 48; item += wcnt) {
        const int l = l_lo + item / 48, n0 = (item % 48) * 128;
        gemv5_item<true>(w_mod + (size_t)l * 1024 * NMOD, NMOD, MapId(), n0, sc, part, b_mod + (size_t)l * NMOD, MODS + (size_t)l * 5 * NMOD, (size_t)NMOD, wave, lane, tid);
    }
    __syncthreads();
}
__device__ __forceinline__ void bias_work_f32(const float* w_in_l, const float* w_ffn_in_l, const float* MODS_l, float* B1_l, float* B2_l, LAS unsigned char* lds, int widx, int wcnt, int wave, int lane, int tid, int item_lo, int item_hi) {
    LAS float* s1 = (LAS float*)lds;
    LAS float* s2 = (LAS float*)(lds + 20480);
    LAS float* part = (LAS float*)(lds + 40960);
    for (int i = tid; i < 5 * 1024; i += NTHR) { const int r = i >> 10, k = i & 1023; s1[i] = MODS_l[(size_t)r * NMOD + k]; s2[i] = MODS_l[(size_t)r * NMOD + 3072 + k]; }
    __syncthreads();
    for (int item = item_lo + widx; item < item_hi; item += wcnt) {
        if (item < 16) gemv5_item<false>(w_in_l, NIN, MapIn(), item * 128, s1, part, nullptr, B1_l, (size_t)NINP, wave, lane, tid);
        else gemv5_item<true>(w_ffn_in_l, NFF, MapF1(), (item - 16) * 128, s2, part, nullptr, B2_l, (size_t)NFF, wave, lane, tid);
    }
    __syncthreads();
}

typedef __attribute__((address_space(4))) const unsigned char* kptr_t;
__device__ __forceinline__ kptr_t kargs() { kptr_t p = (kptr_t)__builtin_amdgcn_kernarg_segment_ptr(); asm volatile("" : "+s"(p)); return p; }
#define KIN(i) (*(const float* const __attribute__((address_space(4)))*)(kp + 8 * (i)))
#define KOUT() (*(float* const __attribute__((address_space(4)))*)(kp + 216))
#define KWS() (*(unsigned char* const __attribute__((address_space(4)))*)(kp + 224))
#define WSP(T, off) ((T*)(ws + (off)))

constexpr int W_IN = 1, W_UQ = 2, W_UKV = 4, W_OUT = 8, W_F1 = 16, W_F2 = 32;
__device__ __forceinline__ void weight_transposes(kptr_t kp, unsigned char* ws, LAS unsigned char* lds, int l, int widx, int wcnt, int wave, int lane, const int mask) {
    LAS unsigned char* scr = lds + wave * 16384;
    constexpr int I_IN = 16 * 16, I_UQ = 6 * 6, I_UKV = 4 * 8, I_OUT = 16 * 8, I_F1 = 16 * 44, I_F2 = 44 * 8;
    const int total = ((mask & W_IN) ? I_IN : 0) + ((mask & W_UQ) ? I_UQ : 0) + ((mask & W_UKV) ? I_UKV : 0) + ((mask & W_OUT) ? I_OUT : 0) + ((mask & W_F1) ? I_F1 : 0) + ((mask & W_F2) ? I_F2 : 0);
    for (int it = widx; it < total; it += wcnt) {
        int r = it;
        if (mask & W_IN) { if (r < I_IN) { transpose_item4(KIN(11) + (size_t)l * 1024 * NIN, NIN, WSP(bf16, WS_WIN) + (size_t)l * NINP * 1024, (size_t)1024, scr, (r / 16) * 64, (r % 16) * 128, lane, MapIn()); continue; } r -= I_IN; }
        if (mask & W_UQ) { if (r < I_UQ) { transpose_item4(KIN(14) + (size_t)l * 384 * 768, 768, WSP(bf16, WS_WUQ) + (size_t)l * 768 * 384, (size_t)384, scr, (r / 6) * 64, (r % 6) * 128, lane, MapUq()); continue; } r -= I_UQ; }
        if (mask & W_UKV) { if (r < I_UKV) { transpose_item4(KIN(16) + (size_t)l * 256 * 1024, 1024, WSP(bf16, WS_WUKV) + (size_t)l * 1024 * 256, (size_t)256, scr, (r / 8) * 64, (r % 8) * 128, lane, MapUkv()); continue; } r -= I_UKV; }
        if (mask & W_OUT) { if (r < I_OUT) { transpose_item4(KIN(20) + (size_t)l * 1024 * 1024, 1024, WSP(bf16, WS_WOUT) + (size_t)l * 1024 * 1024, (size_t)1024, scr, (r / 8) * 64, (r % 8) * 128, lane, MapId()); continue; } r -= I_OUT; }
        if (mask & W_F1) { if (r < I_F1) { transpose_item4(KIN(22) + (size_t)l * 1024 * NFF, NFF, WSP(bf16, WS_WF1), (size_t)1024, scr, (r / 44) * 64, (r % 44) * 128, lane, MapF1()); continue; } r -= I_F1; }
        if (mask & W_F2) transpose_item4(KIN(25) + (size_t)l * DFF * 1024, 1024, WSP(bf16, WS_WF2) + (size_t)l * 1024 * DFF, (size_t)DFF, scr, (r / 8) * 64, (r % 8) * 128, lane, MapId());
    }
}

#ifndef P6_KH
#define P6_KH 8
#endif
#ifndef EN_MASK
#define EN_MASK 0xFFFFF
#endif
#define EN(n) (((EN_MASK) >> (n)) & 1)
#ifndef REP_MASK
#define REP_MASK 0
#endif
#define NREP(n) (1 + (((REP_MASK) >> (n)) & 1))
__global__ void __launch_bounds__(NTHR, 2) fwd_megakernel(Args args) {
    extern __shared__ __attribute__((aligned(16))) unsigned char lds_raw[];
    LAS unsigned char* lds = (LAS unsigned char*)lds_raw;
    const int wave0 = __builtin_amdgcn_readfirstlane((int)threadIdx.x >> 6);
    const int G0 = gridDim.x, bx0 = blockIdx.x;
#define PHASE_VARS() \
    kptr_t kp = kargs(); unsigned char* ws = KWS(); (void)ws; \
    int G = G0, bx = bx0, wave = wave0; asm volatile("" : "+s"(G), "+s"(bx), "+s"(wave)); \
    const int vcu = (G % 8 == 0) ? (bx % 8) * (G / 8) + bx / 8 : bx; \
    const int gw = vcu * NWAVES + wave, NGW = G * NWAVES, NGT = G * NTHR; \
    const int lane = pg8::pg8_lane_id_v(); const int tid = wave * 64 + lane; const int gt = vcu * NTHR + tid; \
    (void)gw; (void)NGW; (void)NGT; (void)gt; (void)tid;

    { PHASE_VARS();
      for (int i = tid; i < 64; i += NTHR) ((LAS unsigned*)(lds + LDS_MISC))[i] = 0u;
      __syncthreads();
      (void)xcd_barrier_post((unsigned*)(ws + WS_CTL) + CW_BAR, (volatile LAS unsigned*)(lds + LDS_MISC + 32), tid == 0); }
#define GRID_BAR_STR2(x) #x
#define GRID_BAR_STR(x) GRID_BAR_STR2(x)
#define GRID_BAR() do { asm volatile("; GRIDBAR line " GRID_BAR_STR(__LINE__)); kptr_t kpb = kargs(); XcdBarrier bb; bb.bar = (unsigned*)((*(unsigned char* const __attribute__((address_space(4)))*)(kpb + 224)) + WS_CTL) + CW_BAR; bb.x = xb_xcc_id(); bb.st = (volatile LAS unsigned*)(lds + LDS_MISC + 32); for (int rb_ = 0; rb_ < NREP(17); ++rb_) xcd_barrier(bb, wave0 == 0 && pg8::pg8_lane_id_v() == 0); } while (0)

    for (int rep_ = 0; rep_ < NREP(0); ++rep_) if (EN(0)) {
        PHASE_VARS();
        mods_work(KIN(6), KIN(7), KIN(8), KIN(9), WSP(float, WS_MODS), lds, 0, 2, bx, G, wave, lane, tid);
    }
    for (int rep_ = 0; rep_ < NREP(1); ++rep_) if (EN(1)) {
        PHASE_VARS();
        const bool act_ = (G != 256) || bx >= 96;
        const int gw_ = (G == 256) ? (bx - 96) * NWAVES + wave : gw, NGW_ = (G == 256) ? 160 * NWAVES : NGW, gt_ = (G == 256) ? (bx - 96) * NTHR + tid : gt, NGT_ = (G == 256) ? 160 * NTHR : NGT; (void)gw_; (void)NGW_; (void)gt_; (void)NGT_;
        if (act_) {
        weight_transposes(kp, ws, lds, 0, gw_, NGW_, wave, lane, W_IN);
        LAS float* scr = (LAS float*)(lds + wave * 16384);
        for (int it = gw_; it < DEPTH * 128; it += NGW_) { const int l = it >> 7, r = it & 127, b = r >> 5, q = r & 31;
            transpose_item(KIN(3) + (size_t)(b * 4 + l) * 256 * 256, 256, WSP(bf16, WS_VTCNA) + (size_t)l * 256 * 1024, DstVFrag(), b * 256, scr, (q / 8) * 64, (q % 8) * 32, lane, MapId()); }
        }
    }
    for (int rep_ = 0; rep_ < NREP(2); ++rep_) if (EN(2)) {
        PHASE_VARS();
        const bool act_ = (G != 256) || bx >= 96;
        const int gw_ = (G == 256) ? (bx - 96) * NWAVES + wave : gw, NGW_ = (G == 256) ? 160 * NWAVES : NGW, gt_ = (G == 256) ? (bx - 96) * NTHR + tid : gt, NGT_ = (G == 256) ? 160 * NTHR : NGT; (void)gw_; (void)NGW_; (void)gt_; (void)NGT_;
        if (act_) {
        const float* cache_na_k = KIN(2); const float* cache_ckv = KIN(4); const float* cache_kr = KIN(5); const float* w_sgu = KIN(18);
        bf16* KCNA = WSP(bf16, WS_KCNA); bf16* CKVC = WSP(bf16, WS_CKVC); bf16* KRC = WSP(bf16, WS_KRC); bf16* WSGU = WSP(bf16, WS_WSGU); float* ROPE = WSP(float, WS_ROPE);
        for (int i = gt_; i < 262144; i += NGT_) {
            const int e = i * 4, c4 = e & 255, key = (e >> 8) & 255, l = (e >> 16) & 3, b = e >> 18;
            const size_t dd = ((size_t)(l * 4 + b) * 256 + key) * 256 + c4;
            *(u32x2*)(KCNA + (size_t)l * 262144 + kfrag_off((unsigned)(b * 256 + key), (unsigned)c4 >> 6, ((unsigned)c4 & 63u) >> 3) + (c4 & 4)) = pack4(*(const f32x4*)(cache_na_k + e)); *(u32x2*)(CKVC + dd) = pack4(*(const f32x4*)(cache_ckv + e));
        }
        for (int i = gt_; i < 32768; i += NGT_) {
            const int e = i * 4, c4 = e & 31, key = (e >> 5) & 255, l = (e >> 13) & 3, b = e >> 15;
            *(u32x2*)(KRC + ((size_t)(l * 4 + b) * 256 + key) * 32 + c4) = pack4(*(const f32x4*)(cache_kr + e));
        }
        for (int i = gt_; i < 65536; i += NGT_) *(u32x2*)(WSGU + (size_t)i * 4) = pack4(*(const f32x4*)(w_sgu + (size_t)i * 4));
        {
            const float* na_rpb = KIN(12); float* BT = WSP(float, WS_NABT);
            for (int i = gt_; i < 4 * 4 * 16 * 4096; i += NGT_) { const int e = i & 3, ln = (i >> 2) & 63, piece = (i >> 8) & 3, half = (i >> 10) & 1, qh = (i >> 11) & 1, ro = (i >> 12) & 15, lh = i >> 16;
                const int c = 32 * qh + (ln & 31), kc = 32 * half + 16 * (piece >> 1) + 8 * (ln >> 5) + 4 * (piece & 1) + e;
                int cs = c - 8; cs = cs < 0 ? 0 : (cs > 48 ? 48 : cs); int co = kc - c; co = co < -15 ? -15 : (co > 15 ? 15 : co);
                const bool ok = (unsigned)(kc - cs) < 16u;
                BT[i] = (ro == 15) ? 0.f : (ok ? na_rpb[(size_t)(lh * 15 + ro) * 31 + co + 15] * LOG2E : NEG_BIG); }
        }
        for (int i = gt_; i < 512; i += NGT_) { const int pos = i >> 3, f = i & 7; const float inv = powf(10000.0f, -(float)f / 8.0f); const float ang = (float)pos * inv; ROPE[2 * i] = cosf(ang); ROPE[2 * i + 1] = sinf(ang); }
        }
    }
    GRID_BAR();
    for (int rep_ = 0; rep_ < NREP(3); ++rep_) if (EN(3)) {
        PHASE_VARS();
        const bf16* WIN = WSP(bf16, WS_WIN); const bf16* WF1 = WSP(bf16, WS_WF1); const float* MODS = WSP(float, WS_MODS); float* B1 = WSP(float, WS_B1); float* B2 = WSP(float, WS_B2);
        for (int it = gw; it < NINP; it += NGW) {
            const int l = it / (NINP + NFF), cc = it % (NINP + NFF);
            const bf16* wrow; const float* sh; float* dst; int dstride;
            if (cc < NINP) { wrow = WIN + ((size_t)l * NINP + cc) * 1024; sh = MODS + (size_t)l * 5 * NMOD; dst = B1 + (size_t)l * 5 * NINP + cc; dstride = NINP; }
            else { wrow = WF1 + ((size_t)l * NFF + (cc - NINP)) * 1024; sh = MODS + (size_t)l * 5 * NMOD + 3072; dst = B2 + (size_t)l * 5 * NFF + (cc - NINP); dstride = NFF; }
            const v4u w0 = *(const v4u*)(wrow + 16 * lane), w1 = *(const v4u*)(wrow + 16 * lane + 8);
            const float wf[16] = {bflo(w0.x), bfhi(w0.x), bflo(w0.y), bfhi(w0.y), bflo(w0.z), bfhi(w0.z), bflo(w0.w), bfhi(w0.w),
                                  bflo(w1.x), bfhi(w1.x), bflo(w1.y), bfhi(w1.y), bflo(w1.z), bfhi(w1.z), bflo(w1.w), bfhi(w1.w)};
#pragma unroll
            for (int r = 0; r < 5; ++r) { const f32x4* sp = (const f32x4*)(sh + (size_t)r * NMOD + 16 * lane); float s = 0.f;
#pragma unroll
                for (int q = 0; q < 4; ++q) { const f32x4 v = sp[q]; s += (v.x * wf[4 * q] + v.y * wf[4 * q + 1]) + (v.z * wf[4 * q + 2] + v.w * wf[4 * q + 3]); }
                s = wave_sum(s); if (lane == 0) dst[(size_t)r * dstride] = s; }
        }
    }
    for (int rep_ = 0; rep_ < NREP(4); ++rep_) if (EN(4)) {
        PHASE_VARS();
        const float* x_prompt = KIN(0); const float* x_sample = KIN(1); const float* g_mix = KIN(10); const float* MODS = WSP(float, WS_MODS); bf16* XA = WSP(bf16, WS_XA); bf16* XR = WSP(bf16, WS_XR); float* SSQX = WSP(float, WS_SSQX);
        for (int m0 = gw; m0 < MT; m0 += 3 * NGW) {
            f32x4 v[3][4];
#pragma unroll
            for (int u = 0; u < 3; ++u) { const int mu = m0 + u * NGW, m = mu < MT ? mu : m0;
                const float* xr = (m < NCTX) ? x_prompt + (size_t)m * DM : x_sample + (size_t)(m - NCTX) * DM;
#pragma unroll
                for (int j = 0; j < 4; ++j) v[u][j] = *(const f32x4*)(xr + 4 * lane + 256 * j); }
#pragma unroll
            for (int u = 0; u < 3; ++u) { const int m = m0 + u * NGW;
                if (m < MT) {
                    const int r = (m < NCTX) ? 0 : 1 + ((m - NCTX) >> 11);
                    const float* sc1 = MODS + (size_t)r * NMOD + 1024;
                    float ss = 0.f;
#pragma unroll
                    for (int j = 0; j < 4; ++j) { const int col = 4 * lane + 256 * j; const f32x4 vv = v[u][j]; ss += sq4(vv);
                        const f32x4 gm = *(const f32x4*)(g_mix + col) * (*(const f32x4*)(sc1 + col) + 1.0f);
                        *(u32x2*)(XA + (size_t)m * DM + col) = pack4(vv * gm); { u32x2 w; w.x = cvtpkh(vv.x, vv.y); w.y = cvtpkh(vv.z, vv.w); *(u32x2*)(XR + (size_t)m * DM + col) = w; } }
                    ss = wave_sum(ss);
                    if (lane < 4) SSQX[(size_t)m * 4 + lane] = (lane == 0) ? ss : 0.f;
                } }
        }
    }
    GRID_BAR();

    for (int l = 0; l < DEPTH; ++l) {
        for (int rep_ = 0; rep_ < NREP(5); ++rep_) if (EN(5)) {
            PHASE_VARS();
            pg8::Gemm g{WSP(bf16, WS_XA), WSP(bf16, WS_WIN) + (size_t)l * NINP * 1024, MT, NINP, 1024}; pg8::StaticOrder S; S.init(MT, NINP, G, bx);
            EpiIn E; E.l = l; E.ws = ws; E.out = KOUT(); E.lds = lds; E.rowfn.ssqx = ws + WS_SSQX; E.colfn.bias = WSP(float, WS_B1) + (size_t)l * 5 * NINP; E.colfn.g_ckv = KIN(15) + l * 256; E.colfn.g_sgu = KIN(17) + l * 256; E.colfn.g_cq = KIN(13) + l * 384;
            if (G == 256) { pg8::SchedP1 S1; S1.init(bx); pg8::gemm_phase<EpiIn, pg8::SchedP1, true, true>(lds, g, S1, E, wave); }
            else pg8::gemm_phase<EpiIn, pg8::StaticOrder, true, true>(lds, g, S, E, wave);
        }
        for (int rep_ = 0; rep_ < NREP(5); ++rep_) {
            PHASE_VARS();
            const int nidle = (G == 256) ? 128 : 0;
            if (nidle == 0 || bx >= 128) {
                const int widx = nidle ? bx - 128 : bx, wcnt = nidle ? nidle : G;
                const int ngemv = wcnt >= 88 ? 44 : 0;
                if (ngemv == 0 || widx < ngemv)
                    bias_work_f32(KIN(11) + (size_t)l * 1024 * NIN, KIN(22) + (size_t)l * 1024 * NFF, WSP(float, WS_MODS) + (size_t)l * 5 * NMOD,
                                  WSP(float, WS_B1) + (size_t)l * 5 * NINP, WSP(float, WS_B2) + (size_t)l * 5 * NFF, lds, widx, ngemv ? ngemv : wcnt, wave, lane, tid, 16, 60);
                if (ngemv == 0 || widx >= ngemv)
                    weight_transposes(kp, ws, lds, l, (ngemv ? widx - ngemv : widx) * NWAVES + wave, (ngemv ? wcnt - ngemv : wcnt) * NWAVES, wave, lane, nidle ? (W_UQ | W_UKV | W_OUT) : (W_UQ | W_UKV | W_OUT | W_F1));
                if (nidle && l + 1 < DEPTH && (ngemv == 0 || widx >= ngemv)) weight_transposes(kp, ws, lds, l + 1, (widx - ngemv) * NWAVES + wave, (wcnt - ngemv) * NWAVES, wave, lane, W_IN);
            }
        }
        GRID_BAR();
        for (int rep_ = 0; rep_ < NREP(6); ++rep_) if (EN(6)) {
            PHASE_VARS();
            pg8::Gemm g{WSP(bf16, WS_CQ), WSP(bf16, WS_WUQ) + (size_t)l * 768 * 384, MT, 768, 384}; pg8::StaticOrder S; S.init(MT, 768, G, G == 256 ? ((bx + 144) & 255) : bx);
            EpiQ E; E.ws = ws; E.lds = lds; E.rowfn.ssq1 = ws + WS_SSQ1;
            pg8::gemm_phase<EpiQ, pg8::StaticOrder, true, true>(lds, g, S, E, wave);
        }
        for (int rep_ = 0; rep_ < NREP(7); ++rep_) for (int part = 0; part < 2; ++part) {
            PHASE_VARS();
            pg8::Gemm g; EpiKV E; pg8::StaticOrder S; E.lds = lds;
            g.Bt = WSP(bf16, WS_WUKV) + (size_t)l * 1024 * 256; g.N = 1024; g.K = 256;
            if (part == 0) { g.A = WSP(bf16, WS_CKV); g.M = MT; E.rowfn.ssq1 = ws + WS_SSQ1; E.rowfn.use = true; E.K = WSP(bf16, WS_KMLA); E.VT = WSP(bf16, WS_VTMLA); E.vtpitch = MT; E.KF = WSP(bf16, WS_KMLA); E.VF = WSP(bf16, WS_VFM); }
            else { g.A = WSP(bf16, WS_CKVC) + (size_t)l * 1024 * 256; g.M = 1024; E.rowfn.ssq1 = ws + WS_SSQ1; E.rowfn.use = false; E.K = WSP(bf16, WS_KCMLA) + (size_t)l * 1024 * 512; E.VT = WSP(bf16, WS_VTCMLA) + (size_t)l * 512 * 1024; E.vtpitch = 1024; E.KF = nullptr; E.VF = nullptr; }
            if (G == 256) { if (part == 0) S.init(g.M, 1024, 112, bx < 112 ? bx : 192); else S.init(g.M, 1024, G, (bx + 176) & 255); }
            else S.init(g.M, 1024, G, bx);
            pg8::gemm_phase<EpiKV, pg8::StaticOrder, true, true>(lds, g, S, E, wave);
        }
        {
            PHASE_VARS();
            if (G == 256 && bx >= 96) weight_transposes(kp, ws, lds, l, (bx - 96) * NWAVES + wave, 160 * NWAVES, wave, lane, W_F1);
        }
        for (int rep_ = 0; rep_ < NREP(8); ++rep_) if (EN(8)) {
            PHASE_VARS(); float* out = KOUT();
            float* RSV = WSP(float, WS_RSV); const float* SSQ1 = WSP(float, WS_SSQ1);
            const bool act_ = (G != 256) || bx >= 96;
            const int gt_ = (G == 256) ? (bx - 96) * NTHR + tid : gt, NGT_ = (G == 256) ? 160 * NTHR : NGT;
            if (act_) for (int m = gt_; m < MT; m += NGT_) RSV[m] = rsqrtf(sum4(*(const f32x4*)(SSQ1 + (size_t)m * 16 + 4)) * (1.0f / 256.0f) + EPS);
            if (act_) for (int i = gt_; i < NCTX * 64; i += NGT_) { const int row = i >> 6, c4 = (i & 63) * 4, b = row >> 8, t = row & 255;
                const float rs = rsqrtf(sum4(*(const f32x4*)(SSQ1 + (size_t)row * 16)) * (1.0f / 256.0f) + EPS);
                f32x4* p = (f32x4*)(out + OUT_CKV + ((size_t)(b * 4 + l) * 256 + t) * 256 + c4); *p = *p * rs; }
        }
        GRID_BAR();
        for (int rep_ = 0; rep_ < NREP(9); ++rep_) if (EN(9)) {
            PHASE_VARS();
            P3Ptrs P; P.ws = ws; P.l = l; P.b_sgu = KIN(19) + l * 512;
            for (int rep2_ = 0; rep2_ < NREP(15); ++rep2_) for (int u = vcu; u < 256; u += G) unit_mla_lat_wg(P, u, wave, pg8::pg8_lane_id_v(), lds);
            for (int rep2_ = 0; rep2_ < NREP(16); ++rep2_) for (int i = gw; i < 2048; i += NGW) {
                const int j = i >> 1;
                if ((i & 1) == 0) unit_na_lat(P, j, pg8::pg8_lane_id_v());
                else { unit_mla_ctx(P, j, pg8::pg8_lane_id_v()); if (j < 512) unit_na_ctx(P, j, pg8::pg8_lane_id_v()); unit_sgu(P, j, pg8::pg8_lane_id_v()); if (j >= 512) unit_sgu(P, j + 512, pg8::pg8_lane_id_v()); }
            }
        }
        GRID_BAR();
        for (int rep_ = 0; rep_ < NREP(10); ++rep_) if (EN(10)) {
            PHASE_VARS(); float* out = KOUT();
            const float* modl = WSP(float, WS_MODS) + (size_t)l * 5 * NMOD;
            pg8::Gemm g{WSP(bf16, WS_MIX), WSP(bf16, WS_WOUT) + (size_t)l * 1024 * 1024, MT, 1024, 1024}; pg8::StaticOrder S; S.init(MT, 1024, G, bx);
            EpiRes<false> E; E.pslot = nullptr; E.pflag = nullptr; E.colfn.gate = modl + 2048; E.colfn.gnext = KIN(21) + l * 1024; E.colfn.scnext = modl + 4096;  E.xr = WSP(bf16, WS_XR); E.XA = WSP(bf16, WS_XA);
            E.ssqx = WSP(float, WS_SSQX); E.lds = lds;
            pg8::gemm_phase<EpiRes<false>, pg8::StaticOrder, true, true>(lds, g, S, E, wave);
        }
        for (int rep_ = 0; rep_ < NREP(10); ++rep_) {
            PHASE_VARS();
            const int nidle = G > 192 ? G - 192 : 0;
            if (nidle == 0 || bx >= 192) {
                const int widx = nidle ? bx - 192 : bx, wcnt = nidle ? nidle : G;
                const int nm = wcnt >= 64 ? 48 : 0;
                if (l + 2 < DEPTH && (nm == 0 || widx < nm)) mods_work(KIN(6), KIN(7), KIN(8), KIN(9), WSP(float, WS_MODS), lds, l + 2, l + 3, widx, nm ? nm : wcnt, wave, lane, tid);
                if (l + 1 < DEPTH && (nm == 0 || widx >= nm))
                    bias_work_f32(KIN(11) + (size_t)(l + 1) * 1024 * NIN, KIN(22) + (size_t)(l + 1) * 1024 * NFF, WSP(float, WS_MODS) + (size_t)(l + 1) * 5 * NMOD,
                                  WSP(float, WS_B1) + (size_t)(l + 1) * 5 * NINP, WSP(float, WS_B2) + (size_t)(l + 1) * 5 * NFF, lds, nm ? widx - nm : widx, nm ? wcnt - nm : wcnt, wave, lane, tid, 0, 16);
                weight_transposes(kp, ws, lds, l, widx * NWAVES + wave, wcnt * NWAVES, wave, lane, W_F2);
                if (l + 1 < DEPTH && G != 256) weight_transposes(kp, ws, lds, l + 1, widx * NWAVES + wave, wcnt * NWAVES, wave, lane, W_IN);
            }
        }
        GRID_BAR();
        for (int rep_ = 0; rep_ < NREP(11); ++rep_) if (EN(11)) {
            PHASE_VARS();
            pg8::Gemm g{WSP(bf16, WS_XA), WSP(bf16, WS_WF1), MT, NFF, 1024}; pg8::StaticOrder S; S.init(MT, NFF, G, bx);
            EpiFF1 E; E.rowfn.ssqx = ws + WS_SSQX; E.colfn.bias = WSP(float, WS_B2) + (size_t)l * 5 * NFF; E.colfn.cw = KIN(23) + (size_t)l * 3 * NFF; E.colfn.cb = KIN(24) + (size_t)l * NFF;
            E.ACT = WSP(bf16, WS_ACT); E.EDGE_A = WSP(float, WS_EDGE_A); E.EDGE_P = WSP(float, WS_EDGE_P); E.lds = lds;
            if (G == 256) {
                pg8::SchedSK5 SK; SK.init(bx, (unsigned*)(ws + WS_CTL) + CW_SKF + l * 256, WSP(float, WS_PART), true);
                pg8::EpiPartOut EP; EP.slot = SK.slot_out(); EP.flag = SK.flag_out(); EP.step = 0;
                pg8::gemm_phase<pg8::EpiPartOut, pg8::SchedSK5, true, true>(lds, g, SK, EP, wave);
                SK.init(bx, (unsigned*)(ws + WS_CTL) + CW_SKF + l * 256, WSP(float, WS_PART), false);
                pg8::gemm_phase<EpiFF1, pg8::SchedSK5, true, true>(lds, g, SK, E, wave);
            }
            else pg8::gemm_phase<EpiFF1, pg8::StaticOrder, true, true>(lds, g, S, E, wave);
        }
        GRID_BAR();
        for (int rep_ = 0; rep_ < NREP(13); ++rep_) if (EN(13)) {
            PHASE_VARS(); float* out = KOUT();
            const float* modl = WSP(float, WS_MODS) + (size_t)l * 5 * NMOD;
            pg8::Gemm g{WSP(bf16, WS_ACT), WSP(bf16, WS_WF2) + (size_t)l * 1024 * DFF, MT, 1024, DFF}; const int ln = (l + 1 < DEPTH) ? l + 1 : l;
            if (G == 256) {
                constexpr int KT = DFF / 64, KH = P6_KH;
                pg8::SchedAssist S; S.init(MT, 1024, G, bx, KT, KH);
                { pg8::Unit u0; for (int i = 0; S.next(i, u0); ++i) conv_fixup(u0.pm, WSP(bf16, WS_ACT), WSP(float, WS_EDGE_A), WSP(float, WS_EDGE_P), KIN(23) + (size_t)l * 3 * NFF, tid); asm volatile("s_waitcnt vmcnt(0)" ::: "memory"); __syncthreads(); }
                unsigned* flg = (unsigned*)(ws + WS_CTL) + CW_SKF + 1024 + l * 192;
                if (bx >= 192) { pg8::EpiPartOut EP; EP.slot = WSP(float, WS_PART) + (size_t)S.c0 * 65536; EP.flag = flg + S.c0; EP.step = 8; pg8::gemm_phase<pg8::EpiPartOut, pg8::SchedAssist, true, true>(lds, g, S, EP, wave); }
                else {
                    EpiRes<true> E; E.pslot = WSP(float, WS_PART) + (size_t)bx * 65536; E.pflag = flg + bx;
                    E.colfn.gate = modl + 5120; E.colfn.gnext = KIN(10) + ln * 1024; E.colfn.scnext = WSP(float, WS_MODS) + (size_t)ln * 5 * NMOD + 1024;  E.xr = WSP(bf16, WS_XR); E.XA = (l + 1 < DEPTH) ? WSP(bf16, WS_XA) : nullptr;
                    E.ssqx = WSP(float, WS_SSQX); E.lds = lds;
                    pg8::gemm_phase<EpiRes<true>, pg8::SchedAssist, true, true>(lds, g, S, E, wave);
                }
            } else {
            pg8::StaticOrder S; S.init(MT, 1024, G, bx);
            { pg8::Unit u0; if (S.next(0, u0)) conv_fixup(u0.pm, WSP(bf16, WS_ACT), WSP(float, WS_EDGE_A), WSP(float, WS_EDGE_P), KIN(23) + (size_t)l * 3 * NFF, tid); asm volatile("s_waitcnt vmcnt(0)" ::: "memory"); __syncthreads(); }
            EpiRes<false> E; E.pslot = nullptr; E.pflag = nullptr; E.colfn.gate = modl + 5120; E.colfn.gnext = KIN(10) + ln * 1024; E.colfn.scnext = WSP(float, WS_MODS) + (size_t)ln * 5 * NMOD + 1024;  E.xr = WSP(bf16, WS_XR); E.XA = (l + 1 < DEPTH) ? WSP(bf16, WS_XA) : nullptr;
            E.ssqx = WSP(float, WS_SSQX); E.lds = lds;
            pg8::gemm_phase<EpiRes<false>, pg8::StaticOrder, true, true>(lds, g, S, E, wave);
            }
        }
        GRID_BAR();
    }
    for (int rep_ = 0; rep_ < NREP(14); ++rep_) if (EN(14)) {
        PHASE_VARS(); float* out = KOUT();
        const float* g_final = KIN(26); const float* SSQX = WSP(float, WS_SSQX); const bf16* XR = WSP(bf16, WS_XR);
        for (int m0 = gw; m0 < MT; m0 += 3 * NGW) {
            u32x2 w[3][4]; f32x4 sq[3];
#pragma unroll
            for (int u = 0; u < 3; ++u) { const int mu = m0 + u * NGW, m = mu < MT ? mu : m0; sq[u] = *(const f32x4*)(SSQX + (size_t)m * 4);
#pragma unroll
                for (int j = 0; j < 4; ++j) w[u][j] = *(const u32x2*)(XR + (size_t)m * DM + 4 * lane + 256 * j); }
#pragma unroll
            for (int u = 0; u < 3; ++u) { const int m = m0 + u * NGW;
                if (m < MT) { float* xr = out + (size_t)m * DM;
                    const float rstd = rsqrtf(sum4(sq[u]) * (1.0f / 1024.0f) + EPS);
#pragma unroll
                    for (int j = 0; j < 4; ++j) { const int col = 4 * lane + 256 * j; const u32x2 ww = w[u][j];
                        const f32x4 vv = (f32x4){hlo(ww.x), hhi(ww.x), hlo(ww.y), hhi(ww.y)} * rstd * *(const f32x4*)(g_final + col); *(f32x4*)(xr + col) = vv; } } }
        }
    }
#undef GRID_BAR
}

extern "C" void kernel_launch(void* const* d_in, const int* in_sizes, int n_in, void* d_out, int out_size, void* d_ws, size_t ws_size, hipStream_t stream) {
    static int grid = 0;
    if (grid == 0) {
        if (n_in != 27 || out_size != (int)OUT_END || ws_size < WS_END) { fprintf(stderr, "kernel_launch: unexpected sizes (n_in %d, out %d, ws %zu; need 27, %zu, >= %zu)\n", n_in, out_size, ws_size, (size_t)OUT_END, (size_t)WS_END); grid = -1; return; }
        int dev = 0, cus = 0, per_cu = 0;
        if (hipGetDevice(&dev) != hipSuccess || hipDeviceGetAttribute(&cus, hipDeviceAttributeMultiprocessorCount, dev) != hipSuccess) { grid = -1; return; }
        if (hipFuncSetAttribute((const void*)fwd_megakernel, hipFuncAttributeMaxDynamicSharedMemorySize, LDS_BYTES) != hipSuccess) { fprintf(stderr, "kernel_launch: hipFuncSetAttribute failed\n"); grid = -1; return; }
        if (hipOccupancyMaxActiveBlocksPerMultiprocessor(&per_cu, (const void*)fwd_megakernel, NTHR, LDS_BYTES) != hipSuccess || per_cu < 1) { fprintf(stderr, "kernel_launch: occupancy query says %d blocks per CU\n", per_cu); per_cu = 1; }
        (void)hipGetLastError();
        grid = cus;
    }
    if (grid < 0) return;
    (void)hipMemsetAsync((char*)d_ws + WS_CTL, 0, CTL_ZERO_BYTES, stream);
    Args a{};
    for (int i = 0; i < 27; ++i) a.in[i] = (const float*)d_in[i];
    a.out = (float*)d_out; a.ws = (unsigned char*)d_ws; a.nphase_lo = 0; a.nphase_hi = 0;
    hipLaunchKernelGGL(fwd_megakernel, dim3(grid), dim3(NTHR), LDS_BYTES, stream, a);
}
```

```cpp
#include <hip/hip_runtime.h>
#include <cstdio>
#include <cstdint>
namespace pg8 {
#define PG8_LAS __attribute__((address_space(3)))
typedef unsigned short bf16_t;
typedef short bf16x8 __attribute__((ext_vector_type(8)));
typedef float f32x4 __attribute__((ext_vector_type(4)));
typedef unsigned u32x4 __attribute__((ext_vector_type(4)));
constexpr int BM = 256, BK = 64, HALF = 128, HTB = HALF * BK * 2  , STAGE_BYTES = 8 * HTB, NXCD = 8, WGM = 8;

__host__ __device__ __forceinline__ int lds_byte(int r, int c) { const int st = (r >> 4) * 2 + (c >> 5), rr = r & 15, cc = c & 31, ob = rr * 64 + cc * 2; return st * 1024 + (ob ^ (((ob >> 9) & 1) << 5)); }
__host__ __device__ __forceinline__ void stage_rc(int b, int& R, int& C) { const int st = b / 1024, sb = b % 1024, swz = sb ^ (((sb >> 9) & 1) << 5); R = (st >> 1) * 16 + swz / 64; C = (st & 1) * 32 + (swz % 64) / 2; }
__host__ __device__ __forceinline__ int perm32(int rho) { const int n = rho >> 4, i = rho & 15; return 8 * (i >> 2) + 4 * n + (i & 3); }

struct Unit { int pm, pn; };
struct Gemm { const bf16_t* A; const bf16_t* Bt; int M, N, K; };

struct StaticOrder {
    static constexpr bool SK = false;
    int nM, nN, nwg, G, c;
    __host__ __device__ __forceinline__ void init(int M, int N, int G_, int c_) { nM = M / BM; nN = N / BM; nwg = nM * nN; G = G_; c = c_; }
    __host__ __device__ __forceinline__ bool next(int i, Unit& u) const {
        const long L = (long)i * G + c; if (L >= nwg) return false;
        int wgid = (int)L; { const int q = nwg / NXCD, r = nwg % NXCD, xcd = wgid % NXCD, off = wgid / NXCD; wgid = (xcd < r ? xcd * (q + 1) : r * (q + 1) + (xcd - r) * q) + off; }
        const int nig = WGM * nN, gid = wgid / nig, fm = gid * WGM, gsz = (nM - fm) < WGM ? (nM - fm) : WGM;
        u.pm = fm + ((wgid % nig) % gsz); u.pn = (wgid % nig) / gsz; return true;
    }
    __device__ __forceinline__ void a_ready(const Unit&, int) const {}
    __device__ __forceinline__ void done(const Unit&) const {}
};
struct SchedSK5 {
    static constexpr bool SK = true;
    int x, g, jj, bx, i0, i1; unsigned* flags; float* part;
    __device__ __forceinline__ void init(int bx_, unsigned* flags_, float* part_, bool tail_call) { bx = bx_; x = bx_ & 7; g = bx_ >> 6; jj = (bx_ >> 3) & 7; flags = flags_; part = part_;
        const int np = jj > 0 ? 1 : 0; i0 = tail_call ? 0 : np; i1 = tail_call ? np : 5; }
    __device__ __forceinline__ bool next(int i_, Unit& u) const {
        const int i = i0 + i_; if (i >= i1) return false;
        const int q = 4 * jj + i; int rho, panel;
        if (q < 32) { panel = q >> 2; rho = ((x & 1) ? (33 * x + 1) / 2 : (33 * x) / 2) + 4 * (q & 3) + g; }
        else { panel = (x & 1) ? 4 + g : g; rho = (x & 1) ? (33 * x - 1) / 2 : (33 * x) / 2 + 16; }
        const int gam = rho / 22; u.pn = rho - 22 * gam; u.pm = 8 * gam + panel; return true;
    }
    __device__ __forceinline__ void piece(int i_, int& kb, int& nt, int& mode) const {
        const int i = i0 + i_; kb = 0; nt = 16; mode = 0;
        if (i == 0 && jj > 0) { kb = 2 * jj; nt = 16 - 2 * jj; mode = 1; }
        if (i == 4 && jj < 7) { nt = 2 * jj + 2; mode = 2; }
    }
    __device__ __forceinline__ float* slot_out() const { return part + (size_t)bx * 65536; }
    __device__ __forceinline__ unsigned* flag_out() const { return flags + bx; }
    __device__ __forceinline__ const float* slot_in() const { return part + (size_t)(bx + 8) * 65536; }
    __device__ __forceinline__ unsigned* flag_in() const { return flags + bx + 8; }
    __device__ __forceinline__ void a_ready(const Unit&, int) const {}
    __device__ __forceinline__ void done(const Unit&) const {}
};
struct SchedAssist {
    static constexpr bool SK = true;
    StaticOrder so; int c0, n, kb, ntp;
    __device__ __forceinline__ void init(int M, int N, int G, int bx, int KT, int KH) { if (bx < 192) { c0 = bx; n = 1; kb = 0; ntp = KT - KH; } else { c0 = (bx & 7) + 24 * ((bx - 192) >> 3); n = 3; kb = KT - KH; ntp = KH; } so.init(M, N, G, 0); }
    __device__ __forceinline__ bool next(int i, Unit& u) const { if (i >= n) return false; StaticOrder s2 = so; s2.c = c0 + 8 * i; return s2.next(0, u); }
    __device__ __forceinline__ void piece(int, int& kb_, int& nt_, int& mode) const { kb_ = kb; nt_ = ntp; mode = 0; }
    __device__ __forceinline__ float* slot_in() const { return nullptr; }
    __device__ __forceinline__ unsigned* flag_in() const { return nullptr; }
    __device__ __forceinline__ void a_ready(const Unit&, int) const {}
    __device__ __forceinline__ void done(const Unit&) const {}
};
struct SchedP1 {
    static constexpr bool SK = false;
    int x, p, s;
    __device__ __forceinline__ void init(int bx) { x = bx & 7; p = (bx >> 3) & 7; s = bx >> 6; }
    __device__ __forceinline__ bool next(int i, Unit& u) const {
        if (i > 1 || (i == 1 && s >= 2)) return false;
        const int ci = s < 2 ? 2 * s + i : s + 2;
        const unsigned pat = (x & 3) == 0 ? 0x542130u : (x & 3) == 1 ? 0xA7968Bu : (x & 3) == 2 ? 0x549687u : 0x543267u;
        const int nib = (int)((pat >> (4 * ci)) & 15u);
        u.pm = 8 * (((6 * x) >> 3) + (nib >> 3)) + p; u.pn = nib & 7; return true;
    }
    __device__ __forceinline__ void a_ready(const Unit&, int) const {}
    __device__ __forceinline__ void done(const Unit&) const {}
};

__device__ __forceinline__ int pg8_lane_id_v() { int l; asm volatile("v_mbcnt_lo_u32_b32 %0, -1, 0\n\tv_mbcnt_hi_u32_b32 %0, -1, %0" : "=v"(l)); return l; }
__device__ __forceinline__ int pg8_lane_id() { return (int)__builtin_amdgcn_mbcnt_hi(~0u, __builtin_amdgcn_mbcnt_lo(~0u, 0u)); }
typedef unsigned long long sk_u64;
typedef unsigned long long sk_u64x2 __attribute__((ext_vector_type(2)));
typedef float sk_f32x2 __attribute__((ext_vector_type(2)));
typedef __bf16 sk_bf16x2 __attribute__((ext_vector_type(2)));
typedef unsigned sk_u32x2 __attribute__((ext_vector_type(2)));
__device__ __forceinline__ sk_u64 sk_pack(const f32x4& v) { sk_f32x2 a = {v.x, v.y}, c = {v.z, v.w}; sk_u32x2 w;
    w.x = __builtin_bit_cast(unsigned, __builtin_convertvector(a, sk_bf16x2)); w.y = __builtin_bit_cast(unsigned, __builtin_convertvector(c, sk_bf16x2)); return __builtin_bit_cast(sk_u64, w); }
__device__ __forceinline__ f32x4 sk_unpack(sk_u64 q) { const sk_u32x2 w = __builtin_bit_cast(sk_u32x2, q); f32x4 v;
    v.x = __builtin_bit_cast(float, w.x << 16); v.y = __builtin_bit_cast(float, w.x & 0xffff0000u); v.z = __builtin_bit_cast(float, w.y << 16); v.w = __builtin_bit_cast(float, w.y & 0xffff0000u); return v; }
__device__ __forceinline__ void sk_store(const f32x4 (&acc)[2][2][4][2], float* slot, unsigned* flag, int wid) {
    const int lane = pg8_lane_id_v(); const unsigned o = (unsigned)(wid * 64 + lane) * 16u;
    const __amdgpu_buffer_rsrc_t rs = __builtin_amdgcn_make_buffer_rsrc(slot, 0, 131072, 0x00020000);
#pragma unroll
    for (int a = 0; a < 2; ++a)
#pragma unroll
        for (int b = 0; b < 2; ++b) {
            asm volatile("" ::: "memory"); __builtin_amdgcn_sched_barrier(0);
#pragma unroll
            for (int m = 0; m < 4; ++m) { const unsigned i = (unsigned)((a * 2 + b) * 4 + m); sk_u64x2 w; w.x = sk_pack(acc[a][b][m][0]); w.y = sk_pack(acc[a][b][m][1]);
                __builtin_amdgcn_raw_buffer_store_b128(__builtin_bit_cast(u32x4, w), rs, o + i * 8192u, 0,   16); }
        }
    asm volatile("s_waitcnt vmcnt(0)" ::: "memory");
    __builtin_amdgcn_s_barrier();
    if (wid == 0 && lane == 0) __hip_atomic_store(flag, 1u, __ATOMIC_RELAXED, __HIP_MEMORY_SCOPE_AGENT);
}
__device__ __forceinline__ void sk_load_init(f32x4 (&acc)[2][2][4][2], const float* slot, unsigned* flag, int wid) {
    const int lane = pg8_lane_id_v();
    if (wid == 0 && lane == 0) { unsigned sp = 0;
        while (__hip_atomic_load(flag, __ATOMIC_RELAXED, __HIP_MEMORY_SCOPE_AGENT) == 0u) { __builtin_amdgcn_s_sleep(1); if (++sp > (1u << 22)) break; }
        asm volatile("s_waitcnt vmcnt(0)" ::: "memory"); }
    __builtin_amdgcn_s_barrier();
    const unsigned o = (unsigned)(wid * 64 + lane) * 16u;
    const __amdgpu_buffer_rsrc_t rs = __builtin_amdgcn_make_buffer_rsrc((void*)slot, 0, 131072, 0x00020000);
#pragma unroll
    for (int a = 0; a < 2; ++a)
#pragma unroll
        for (int b = 0; b < 2; ++b)
#pragma unroll
            for (int m = 0; m < 4; ++m) { const unsigned i = (unsigned)((a * 2 + b) * 4 + m);
                const sk_u64x2 w = __builtin_bit_cast(sk_u64x2, __builtin_amdgcn_raw_buffer_load_b128(rs, o + i * 8192u, 0,   16));
                acc[a][b][m][0] = sk_unpack(w.x); acc[a][b][m][1] = sk_unpack(w.y); }
}
struct EpiPartOut {
    static constexpr bool PERM = true, AFTER_DRAIN = false;
    float* slot; unsigned* flag; int step;
    __device__ __forceinline__ void prefill(const Unit&, int, int, int, int) const {}
    __device__ __forceinline__ void operator()(const f32x4 (&acc)[2][2][4][2], const Unit&, int wr, int wc, int, int, int ui, const Unit&) const { sk_store(acc, slot + (size_t)(ui * step) * 65536, flag + ui * step, wr * 4 + wc); }
};
template <class Epi, class Sched, bool ALIGN_EPI = false, bool SP2 = false>
__device__ __forceinline__ void gemm_phase(PG8_LAS unsigned char* lds, const Gemm g, const Sched& S, const Epi& E, const int wid_in) {
    const int lane = pg8_lane_id_v(), wid = wid_in, tid = wid * 64 + lane, wr = wid >> 2, wc = wid & 3, fr = lane & 15, fq = lane >> 4;
    const int K = g.K; int nt = K / BK;
    unsigned voffA[2], voffB[2];
#define PG8_LANE_OFFS(tid_) do { _Pragma("unroll") for (int i = 0; i < 2; ++i) { int R, C; stage_rc((tid_) * 16 + i * 8192, R, C); const int Rb = Epi::PERM ? ((R & ~31) + perm32(R & 31)) : R; \
        voffA[i] = (unsigned)(R * K + C) * 2u; voffB[i] = (unsigned)(Rb * K + C) * 2u; } } while (0)
    PG8_LANE_OFFS(tid);
    const size_t kstep = (size_t)(BK * 2);
    const size_t hstep = (size_t)HALF * K * 2;
    const size_t tstep = 2 * hstep;
    const unsigned ldsw = (unsigned)wid * 1024u;
    int aoff = lds_byte(wr * 64 + fr, fq * 8), boff = lds_byte(wc * 32 + fr, fq * 8);
#define PG8_SA(b, h) (((b) * 2 + (h)) * HTB)
#define PG8_SB(b, h) ((4 + (b) * 2 + (h)) * HTB)
#define PG8_STAGE(bufoff, gbase, voff) do { _Pragma("unroll") for (int _i = 0; _i < 2; ++_i) \
        __builtin_amdgcn_global_load_lds((const unsigned*)((const char*)(gbase) + (voff)[_i]), (PG8_LAS unsigned*)(lds + (bufoff) + ldsw + _i * 8192), 16, 0, 0); } while (0)
#define PG8_LDA(dst, b, h) do { _Pragma("unroll") for (int m = 0; m < 4; ++m) _Pragma("unroll") for (int k = 0; k < 2; ++k) dst[m][k] = *(const PG8_LAS bf16x8*)(lds + PG8_SA(b, h) + aoff + m * 2048 + k * 1024); } while (0)
#define PG8_LDB(dst, b, h) do { _Pragma("unroll") for (int n = 0; n < 2; ++n) _Pragma("unroll") for (int k = 0; k < 2; ++k) dst[n][k] = *(const PG8_LAS bf16x8*)(lds + PG8_SB(b, h) + boff + n * 2048 + k * 1024); } while (0)
#define PG8_MMA(ai, bj, At, Bt) do { __builtin_amdgcn_s_setprio(1); _Pragma("unroll") for (int m = 0; m < 4; ++m) _Pragma("unroll") for (int n = 0; n < 2; ++n) _Pragma("unroll") for (int k = 0; k < 2; ++k) \
        acc[ai][bj][m][n] = __builtin_amdgcn_mfma_f32_16x16x32_bf16(Bt[n][k], At[m][k], acc[ai][bj][m][n], 0, 0, 0); __builtin_amdgcn_s_setprio(0); } while (0)
#define PG8_WAIT_V(n) asm volatile("s_waitcnt vmcnt(" #n ")" ::: "memory")
#define PG8_WAIT_L(n) asm volatile("s_waitcnt lgkmcnt(" #n ")" ::: "memory")
#define PG8_BAR __builtin_amdgcn_s_barrier()
#define PG8_SCHED __builtin_amdgcn_sched_barrier(0)
    Unit cur, nxt; int ui = 0;
    if (!S.next(0, cur)) return;
    f32x4 acc[2][2][4][2];
#pragma unroll
    for (int a = 0; a < 2; ++a)
#pragma unroll
        for (int b = 0; b < 2; ++b)
#pragma unroll
            for (int m = 0; m < 4; ++m)
#pragma unroll
                for (int n = 0; n < 2; ++n) acc[a][b][m][n] = (f32x4){0.f, 0.f, 0.f, 0.f};
    bf16x8 At[4][2], B0[2][2], B1[2][2];
    const char* cA = (const char*)g.A + (size_t)cur.pm * tstep; const char* cB = (const char*)g.Bt + (size_t)cur.pn * tstep;
    int nt_n = nt, md_n = 0;
    if constexpr (Sched::SK) { int kb, md; S.piece(0, kb, nt, md); cA += (size_t)kb * kstep; cB += (size_t)kb * kstep; }
    S.a_ready(cur, 0);
    if constexpr (!Epi::AFTER_DRAIN) E.prefill(cur, wr, wc, fr, fq);
    if constexpr (SP2) {
        PG8_STAGE(PG8_SB(0, 0), cB, voffB); PG8_STAGE(PG8_SB(0, 1), cB + hstep, voffB); PG8_STAGE(PG8_SA(0, 0), cA, voffA); PG8_STAGE(PG8_SA(0, 1), cA + hstep, voffA);
        if (wr == 1) PG8_BAR;
        PG8_WAIT_V(2); PG8_BAR;
        PG8_STAGE(PG8_SB(1, 0), cB + kstep, voffB); PG8_STAGE(PG8_SA(1, 0), cA + kstep, voffA); PG8_STAGE(PG8_SB(1, 1), cB + hstep + kstep, voffB);
        PG8_WAIT_V(6); PG8_BAR;
    } else {
        PG8_STAGE(PG8_SB(0, 0), cB, voffB); PG8_STAGE(PG8_SA(0, 0), cA, voffA); PG8_STAGE(PG8_SB(0, 1), cB + hstep, voffB); PG8_STAGE(PG8_SA(0, 1), cA + hstep, voffA);
        if (wr == 1) PG8_BAR;
        PG8_WAIT_V(4); PG8_BAR;
        PG8_STAGE(PG8_SB(1, 0), cB + kstep, voffB); PG8_STAGE(PG8_SA(1, 0), cA + kstep, voffA); PG8_STAGE(PG8_SB(1, 1), cB + hstep + kstep, voffB);
        PG8_WAIT_V(6); PG8_BAR;
    }
    for (;;) {
        const bool has_next = S.next(ui + 1, nxt);
        if (!has_next) nxt = cur;
        const char* nA = has_next ? (const char*)g.A + (size_t)nxt.pm * tstep : cA; const char* nB = has_next ? (const char*)g.Bt + (size_t)nxt.pn * tstep : cB;
        if constexpr (Sched::SK) { if (has_next) { int kb; S.piece(ui + 1, kb, nt_n, md_n); nA += (size_t)kb * kstep; nB += (size_t)kb * kstep; } }
        for (int t = 0; t < nt; t += 2) {
            const bool last = (t == nt - 2);
            const char* a1 = cA + (size_t)(t + 1) * kstep;
            const char* a2 = last ? nA : cA + (size_t)(t + 2) * kstep; const char* b2 = last ? nB : cB + (size_t)(t + 2) * kstep;
            const char* a3 = a2 + kstep; const char* b3 = b2 + kstep;
            if (last && has_next) S.a_ready(nxt, ui + 1);
            if constexpr (SP2) {
            PG8_LDB(B0, 0, 0); PG8_LDB(B1, 0, 1); PG8_SCHED; PG8_LDA(At, 0, 0); PG8_STAGE(PG8_SA(1, 1), a1 + hstep, voffA);
            PG8_WAIT_V(8); PG8_WAIT_L(0); PG8_BAR; PG8_MMA(0, 0, At, B0); PG8_MMA(0, 1, At, B1); PG8_BAR; PG8_SCHED;
            PG8_LDA(At, 0, 1); PG8_STAGE(PG8_SB(0, 0), b2, voffB); PG8_STAGE(PG8_SB(0, 1), b2 + hstep, voffB); PG8_STAGE(PG8_SA(0, 0), a2, voffA);
            PG8_WAIT_V(8); PG8_WAIT_L(0); PG8_BAR; PG8_MMA(1, 0, At, B0); PG8_MMA(1, 1, At, B1); PG8_BAR; PG8_SCHED;
            PG8_LDB(B0, 1, 0); PG8_LDB(B1, 1, 1); PG8_SCHED; PG8_LDA(At, 1, 0); PG8_STAGE(PG8_SA(0, 1), a2 + hstep, voffA);
            PG8_WAIT_V(8); PG8_WAIT_L(0); PG8_BAR; PG8_MMA(0, 0, At, B0); PG8_MMA(0, 1, At, B1); PG8_BAR; PG8_SCHED;
            PG8_LDA(At, 1, 1); PG8_STAGE(PG8_SB(1, 0), b3, voffB); PG8_STAGE(PG8_SB(1, 1), b3 + hstep, voffB); PG8_STAGE(PG8_SA(1, 0), a3, voffA);
            PG8_WAIT_V(8); PG8_WAIT_L(0); PG8_BAR; PG8_MMA(1, 0, At, B0); PG8_MMA(1, 1, At, B1); PG8_BAR; PG8_SCHED;
            } else {
            PG8_LDB(B0, 0, 0); PG8_SCHED; PG8_LDA(At, 0, 0); PG8_STAGE(PG8_SA(1, 1), a1 + hstep, voffA);
            PG8_WAIT_L(8); PG8_BAR; PG8_WAIT_L(0); PG8_MMA(0, 0, At, B0); PG8_BAR; PG8_SCHED;
            PG8_LDB(B1, 0, 1); PG8_STAGE(PG8_SB(0, 0), b2, voffB);
            PG8_BAR; PG8_WAIT_L(0); PG8_MMA(0, 1, At, B1); PG8_BAR;
            PG8_LDA(At, 0, 1); PG8_STAGE(PG8_SA(0, 0), a2, voffA);
            PG8_BAR; PG8_WAIT_L(0); PG8_MMA(1, 0, At, B0); PG8_BAR; PG8_SCHED;
            PG8_STAGE(PG8_SB(0, 1), b2 + hstep, voffB);
            PG8_WAIT_V(6); PG8_BAR; PG8_MMA(1, 1, At, B1); PG8_BAR;
            PG8_LDB(B0, 1, 0); PG8_SCHED; PG8_LDA(At, 1, 0); PG8_STAGE(PG8_SA(0, 1), a2 + hstep, voffA);
            PG8_WAIT_L(8); PG8_BAR; PG8_WAIT_L(0); PG8_MMA(0, 0, At, B0); PG8_BAR; PG8_SCHED;
            PG8_LDB(B1, 1, 1); PG8_STAGE(PG8_SB(1, 0), b3, voffB);
            PG8_BAR; PG8_WAIT_L(0); PG8_MMA(0, 1, At, B1); PG8_BAR;
            PG8_LDA(At, 1, 1); PG8_STAGE(PG8_SA(1, 0), a3, voffA);
            PG8_BAR; PG8_WAIT_L(0); PG8_MMA(1, 0, At, B0); PG8_BAR; PG8_SCHED;
            PG8_STAGE(PG8_SB(1, 1), b3 + hstep, voffB);
            PG8_WAIT_V(6); PG8_BAR; PG8_MMA(1, 1, At, B1); PG8_BAR;
            }
        }
        if constexpr (ALIGN_EPI) { if (wr == 0) PG8_BAR; }
        if constexpr (!Epi::AFTER_DRAIN) { const int l2 = pg8_lane_id_v(); E(acc, cur, wr, wc, l2 & 15, l2 >> 4, ui, nxt); S.done(cur); }
        if (!has_next) break;
        bool zero = true;
        if constexpr (Sched::SK) { if (md_n == 2) { sk_load_init(acc, S.slot_in(), S.flag_in(), wid); zero = false; } }
        if (zero) {
#pragma unroll
        for (int a = 0; a < 2; ++a)
#pragma unroll
            for (int b = 0; b < 2; ++b)
#pragma unroll
                for (int m = 0; m < 4; ++m)
#pragma unroll
                    for (int n = 0; n < 2; ++n) acc[a][b][m][n] = (f32x4){0.f, 0.f, 0.f, 0.f};
        }
        cur = nxt; cA = nA; cB = nB; ++ui;
        { const int l3 = pg8_lane_id_v(); PG8_LANE_OFFS(wid * 64 + l3); aoff = lds_byte(wr * 64 + (l3 & 15), (l3 >> 4) * 8); boff = lds_byte(wc * 32 + (l3 & 15), (l3 >> 4) * 8); }
        if constexpr (Sched::SK) nt = nt_n;
        if constexpr (ALIGN_EPI) { if (wr == 1) PG8_BAR; }
    }
    PG8_WAIT_V(0);
    if constexpr (!ALIGN_EPI) { if (wr == 0) PG8_BAR; }
    PG8_BAR;
    if constexpr (Epi::AFTER_DRAIN) { E.fused(acc, cur, wr, wc, fr, fq, lds, wid, lane); S.done(cur); }
#undef PG8_LANE_OFFS
#undef PG8_SA
#undef PG8_SB
#undef PG8_STAGE
#undef PG8_LDA
#undef PG8_LDB
#undef PG8_MMA
#undef PG8_WAIT_V
#undef PG8_WAIT_L
#undef PG8_BAR
#undef PG8_SCHED
}
}

#define GAS __attribute__((address_space(1)))
#define LAS __attribute__((address_space(3)))
typedef unsigned short bf16;
typedef unsigned v4u __attribute__((ext_vector_type(4)));
typedef float f32x4 __attribute__((ext_vector_type(4)));
typedef short bf16x8 __attribute__((ext_vector_type(8)));
typedef GAS unsigned gu32;
typedef GAS unsigned long long gu64;
#define RLX_AGENT __ATOMIC_RELAXED, __HIP_MEMORY_SCOPE_AGENT
#define LDS_WAIT() asm volatile("s_waitcnt lgkmcnt(0)" ::: "memory")
#define VM_WAIT() asm volatile("s_waitcnt vmcnt(0)" ::: "memory")
__device__ __forceinline__ unsigned long long rt() { return __builtin_amdgcn_s_memrealtime(); }
__device__ __forceinline__ unsigned f2bf(float f) { unsigned u = __builtin_bit_cast(unsigned, f); return (u + 0x7fffu + ((u >> 16) & 1u)) >> 16; }
__device__ __forceinline__ unsigned pk2(float lo, float hi) { return f2bf(lo) | (f2bf(hi) << 16); }

#define XB_TMO      128
#define XB_XCNT(j)  (256  + 64 * (j))
#define XB_XSUB(j)  (1280 + 64 * (j))
#define XB_XGEN(j)  (2304 + 64 * (j))
#define XB_TOP      3328
#define XB_TOPGEN   3392
#define XCD_BAR_WORDS 3456
#define XB_SPIN_CAP (1u << 18)

__device__ __forceinline__ unsigned xb_ld(unsigned* p)              { return __hip_atomic_load(p, __ATOMIC_RELAXED, __HIP_MEMORY_SCOPE_AGENT); }
__device__ __forceinline__ unsigned xb_add(unsigned* p, unsigned v) { return __hip_atomic_fetch_add(p, v, __ATOMIC_RELAXED, __HIP_MEMORY_SCOPE_AGENT); }
__device__ __forceinline__ unsigned xb_xcc_id() { return (unsigned)__builtin_amdgcn_s_getreg((3 << 11) | 20) & 0xFu; }
#define XB_SPIN(cond, bar) do { unsigned _sp = 0; while (cond) { __builtin_amdgcn_s_sleep(1); \
    if ((++_sp & 255u) == 0u) { if (xb_ld(&(bar)[XB_TMO])) break; if (_sp > XB_SPIN_CAP) { atomicAdd(&(bar)[XB_TMO], 1u); break; } } } } while (0)

struct XcdBarrier {
    unsigned* bar; unsigned x;
    volatile LAS unsigned* st;
};

__device__ __forceinline__ XcdBarrier xcd_barrier_post(unsigned* bar, volatile LAS unsigned* st, const bool t0) {
    XcdBarrier b; b.bar = bar; b.x = xb_xcc_id(); b.st = st;
    if (t0) (void)xb_add(&bar[XB_XCNT(b.x)], 1u);
    return b;
}
__device__ __forceinline__ void xcd_barrier_complete(unsigned* bar, unsigned x, unsigned& nloc, unsigned& nx) {
    const unsigned G = gridDim.x * gridDim.y * gridDim.z;
    unsigned sum, cnt, mine, sp = 0u;
    for (;;) {
        sum = 0u; cnt = 0u; mine = 0u;
#pragma unroll
        for (unsigned j = 0; j < 16; ++j) { const unsigned c = xb_ld(&bar[XB_XCNT(j)]); sum += c; cnt += (c > 0u) ? 1u : 0u; mine = (j == x) ? c : mine; }
        if (sum == G) break;
        __builtin_amdgcn_s_sleep(1);
        if ((++sp & 255u) == 0u) { if (xb_ld(&bar[XB_TMO])) break; if (sp > XB_SPIN_CAP) { atomicAdd(&bar[XB_TMO], 1u); break; } }
    }
    nloc = mine > 0u ? mine : 1u; nx = cnt > 0u ? cnt : 1u;
}

__device__ __forceinline__ void xcd_barrier(const XcdBarrier& b, const bool t0) {
    asm volatile("s_waitcnt vmcnt(0)" ::: "memory");
    __syncthreads();
    if (t0) {
        unsigned* bar = b.bar;
        __builtin_amdgcn_s_waitcnt(0);
        unsigned nloc = b.st[0], nx = b.st[1];
        if (nloc == 0u) { xcd_barrier_complete(bar, b.x, nloc, nx); b.st[0] = nloc; b.st[1] = nx; }
        const unsigned old = xb_add(&bar[XB_XSUB(b.x)], 1u);
        const unsigned gen = old / nloc;
        if (old + 1u == (gen + 1u) * nloc) {
            __builtin_amdgcn_fence(__ATOMIC_RELEASE, "agent");
            asm volatile("s_waitcnt vmcnt(0)" ::: "memory");
            const unsigned og = xb_add(&bar[XB_TOP], 1u);
            const unsigned tg = og / nx;
            if (og + 1u == (tg + 1u) * nx) xb_add(&bar[XB_TOPGEN], 1u);
            else XB_SPIN(xb_ld(&bar[XB_TOPGEN]) == tg, bar);
            __builtin_amdgcn_fence(__ATOMIC_ACQUIRE, "agent");
            xb_add(&bar[XB_XGEN(b.x)], 1u);
            asm volatile("s_waitcnt vmcnt(0)" ::: "memory");
        } else {
            XB_SPIN(xb_ld(&bar[XB_XGEN(b.x)]) == gen, bar);
            __builtin_amdgcn_fence(__ATOMIC_ACQUIRE, "agent");
            asm volatile("s_waitcnt vmcnt(0)" ::: "memory");
        }
    }
    __syncthreads();
}


typedef float f32x16 __attribute__((ext_vector_type(16)));
typedef float f32x2 __attribute__((ext_vector_type(2)));
typedef unsigned u32x2 __attribute__((ext_vector_type(2)));
typedef __bf16 bf16x2_t __attribute__((ext_vector_type(2)));

constexpr int DM = 1024, NCTX = 4096, NLAT = 8192, MT = 12288, DEPTH = 4;
constexpr int NINP = 2048, NIN = 1952, DFF = 2816, NFF = 5632, NMOD = 6144;
constexpr float EPS = 1e-6f;
constexpr float LOG2E = 1.4426950408889634f;
constexpr float QS_NA = 0.125f * LOG2E;
constexpr float QS_MLA = 0.10206207261596575f * LOG2E;
constexpr float NEG_BIG = -1e30f;

constexpr size_t OUT_X = 0;
constexpr size_t OUT_NK = 12582912, OUT_NV = 16777216, OUT_CKV = 20971520, OUT_KR = 25165824, OUT_END = 25690112;

constexpr size_t KiB = 1024, MiB = 1u << 20;
constexpr size_t WS_CTL = 0, CTL_ZERO_BYTES = 1 * MiB;
constexpr size_t WS_ROPE = 1 * MiB;
constexpr size_t WS_MODS = WS_ROPE + 4 * KiB;
constexpr size_t WS_B1 = WS_MODS + 491520;
constexpr size_t WS_B2 = WS_B1 + 163840;
constexpr size_t WS_RSV = WS_B2 + 450560;
constexpr size_t WS_SSQX = WS_RSV + 49152;
constexpr size_t WS_SSQ1 = WS_SSQX + 786432;
constexpr size_t WS_WSGU = WS_SSQ1 + 786432;
static_assert(WS_WSGU + 524288 <= 8 * MiB, "ws map");
constexpr size_t WS_WIN = 8 * MiB;
constexpr size_t WS_WUQ = 24 * MiB;
constexpr size_t WS_WUKV = 27 * MiB;
constexpr size_t WS_WOUT = 29 * MiB;
constexpr size_t WS_WF1 = 37 * MiB;
constexpr size_t WS_XR = 49 * MiB;
constexpr size_t WS_WF2 = 81 * MiB;
constexpr size_t WS_KCNA = 103 * MiB;
constexpr size_t WS_VTCNA = 105 * MiB;
constexpr size_t WS_CKVC = 107 * MiB;
constexpr size_t WS_KRC = 109 * MiB;
constexpr size_t WS_KCMLA = 110 * MiB;
constexpr size_t WS_VTCMLA = 114 * MiB;
constexpr size_t WS_XA = 118 * MiB;
constexpr size_t WS_T = 142 * MiB;
constexpr size_t WS_QNA = WS_T, WS_KNA = WS_T + 6 * MiB, WS_VTNA = WS_T + 12 * MiB, WS_CQ = WS_T + 18 * MiB, WS_CKV = WS_T + 27 * MiB, WS_KR = WS_T + 33 * MiB,
                 WS_U = WS_T + 34 * MiB, WS_VTSGU = WS_T + 40 * MiB, WS_QMLA = WS_T + 46 * MiB, WS_KMLA = WS_T + 64 * MiB, WS_VTMLA = WS_T + 76 * MiB, WS_MIX = WS_T + 88 * MiB;
constexpr size_t WS_VFM = WS_T + 112 * MiB, WS_KRF = WS_T + 116 * MiB;
constexpr size_t WS_PART = WS_T;
constexpr int CW_SKF = 16384;
constexpr size_t WS_AFF = WS_T, WS_ACT = WS_T + 132 * MiB;
constexpr size_t WS_EDGE_A = WS_T + 198 * MiB;
constexpr size_t WS_EDGE_P = WS_T + 201 * MiB;
constexpr size_t WS_NABT = WS_T + 204 * MiB;
constexpr size_t WS_END = WS_T + 208 * MiB;
constexpr int CW_BAR = 4096;

constexpr int RING_BYTES = 131072;
constexpr int LDS_MISC = RING_BYTES;
constexpr int LDS_RPB = RING_BYTES + 256;
constexpr int LDS_WSCR = RING_BYTES + 8192;
constexpr int LDS_TAB = RING_BYTES + 24576;
constexpr int LDS_BYTES = RING_BYTES + 30720;
constexpr int NWAVES = 8, NTHR = 512;

struct Args {
    const float* in[27];
    float* out; unsigned char* ws;
    int nphase_lo, nphase_hi;
};

__device__ __forceinline__ unsigned cvtpk(float lo, float hi) { f32x2 v = {lo, hi}; bf16x2_t b = __builtin_convertvector(v, bf16x2_t); return __builtin_bit_cast(unsigned, b); }
__device__ __forceinline__ float bf2f(unsigned short b) { return __uint_as_float((unsigned)b << 16); }
__device__ __forceinline__ float bflo(unsigned w) { return __uint_as_float(w << 16); }
typedef _Float16 h16x2_t __attribute__((ext_vector_type(2)));
__device__ __forceinline__ unsigned cvtpkh(float lo, float hi) { h16x2_t h = {(_Float16)lo, (_Float16)hi}; return __builtin_bit_cast(unsigned, h); }
__device__ __forceinline__ float hlo(unsigned w) { const h16x2_t h = __builtin_bit_cast(h16x2_t, w); return (float)h.x; }
__device__ __forceinline__ float hhi(unsigned w) { const h16x2_t h = __builtin_bit_cast(h16x2_t, w); return (float)h.y; }
__device__ __forceinline__ float bfhi(unsigned w) { return __uint_as_float(w & 0xffff0000u); }
__device__ __forceinline__ float fast_exp2(float x) { return __builtin_amdgcn_exp2f(x); }
__device__ __forceinline__ float fast_rcp(float x) { return __builtin_amdgcn_rcpf(x); }
__device__ __forceinline__ float silu_f(float x) { return x * fast_rcp(1.0f + fast_exp2(-x * LOG2E)); }
__device__ __forceinline__ float gelu_tanh_f(float x) {
    const float u = 0.7978845608028654f * (x + 0.044715f * x * x * x);
    return x * fast_rcp(1.0f + fast_exp2(-2.0f * LOG2E * u));
}
__device__ __forceinline__ float xsum32(float v) { auto r = __builtin_amdgcn_permlane32_swap(__float_as_uint(v), __float_as_uint(v), false, false); return __uint_as_float(r[0]) + __uint_as_float(r[1]); }
__device__ __forceinline__ float xmax32(float v) { auto r = __builtin_amdgcn_permlane32_swap(__float_as_uint(v), __float_as_uint(v), false, false); return fmaxf(__uint_as_float(r[0]), __uint_as_float(r[1])); }
__device__ __forceinline__ float xsum16(float v) { auto r = __builtin_amdgcn_permlane16_swap(__float_as_uint(v), __float_as_uint(v), false, false); return __uint_as_float(r[0]) + __uint_as_float(r[1]); }
template <int CTRL> __device__ __forceinline__ float dpp_keep_f(float old, float v) { return __uint_as_float((unsigned)__builtin_amdgcn_update_dpp((int)__float_as_uint(old), (int)__float_as_uint(v), CTRL, 0xf, 0xf, false)); }
template <int CTRL> __device__ __forceinline__ float dpp_f(float v) { return __uint_as_float((unsigned)__builtin_amdgcn_update_dpp(0, (int)__float_as_uint(v), CTRL, 0xf, 0xf, true)); }
__device__ __forceinline__ float wave_sum(float v) {
    v += dpp_f<0xB1>(v);
    v += dpp_f<0x4E>(v);
    v += dpp_f<0x124>(v);
    v += dpp_f<0x128>(v);
    v = xsum16(v); v = xsum32(v);
    return v;
}

__host__ __device__ __forceinline__ unsigned kfrag_off(unsigned m, unsigned h, unsigned d8) { const unsigned kk = m & 31u, kp = (kk & ~12u) | ((kk & 8u) >> 1) | ((kk & 4u) << 1); return ((((m >> 5) * 4u + h) * 4u + (d8 >> 1)) * 64u + (d8 & 1u) * 32u + kp) * 8u; }
__host__ __device__ __forceinline__ unsigned vfrag_off(unsigned m8, unsigned h, unsigned d) { const unsigned k8 = (m8 & 31u) >> 3; return (((((m8 >> 5) * 4u + h) * 2u + (d >> 5)) * 2u + (k8 >> 1)) * 64u + (k8 & 1u) * 32u + (d & 31u)) * 8u; }
__host__ __device__ __forceinline__ unsigned kfrag8_off(unsigned m, unsigned h, unsigned d8) { const unsigned kk = m & 31u, kp = (kk & ~12u) | ((kk & 8u) >> 1) | ((kk & 4u) << 1); return ((((m >> 5) * 8u + h) * 4u + (d8 >> 1)) * 64u + (d8 & 1u) * 32u + kp) * 8u; }
__host__ __device__ __forceinline__ unsigned vfrag8_off(unsigned m8, unsigned h, unsigned d) { const unsigned k8 = (m8 & 31u) >> 3; return (((((m8 >> 5) * 8u + h) * 2u + (d >> 5)) * 2u + (k8 >> 1)) * 64u + (k8 & 1u) * 32u + (d & 31u)) * 8u; }
__host__ __device__ __forceinline__ unsigned krfrag_off(unsigned m, unsigned part, unsigned hi) { const unsigned kk = m & 31u, kp = (kk & ~12u) | ((kk & 8u) >> 1) | ((kk & 4u) << 1); return (((m >> 5) * 2u + part) * 64u + hi * 32u + kp) * 8u; }
__device__ __forceinline__ int modrow(int pm) { return pm < 16 ? 0 : 1 + ((pm - 16) >> 3); }


__device__ __forceinline__ v4u pack8(const f32x4& a, const f32x4& b) { v4u w; w.x = cvtpk(a.x, a.y); w.y = cvtpk(a.z, a.w); w.z = cvtpk(b.x, b.y); w.w = cvtpk(b.z, b.w); return w; }
__device__ __forceinline__ u32x2 pack4(const f32x4& a) { u32x2 w; w.x = cvtpk(a.x, a.y); w.y = cvtpk(a.z, a.w); return w; }
__device__ __forceinline__ float sum4(const f32x4& a) { return (a.x + a.y) + (a.z + a.w); }
__device__ __forceinline__ float sq4(const f32x4& a) { return (a.x * a.x + a.y * a.y) + (a.z * a.z + a.w * a.w); }
__device__ __forceinline__ float sum16f(const float* p) { const f32x4* q = (const f32x4*)p; return (sum4(q[0]) + sum4(q[1])) + (sum4(q[2]) + sum4(q[3])); }
template <class T> __device__ __forceinline__ T ldg(const void* base, unsigned boff) { return *(const T*)((const char*)base + boff); }
template <class T> __device__ __forceinline__ void stg(void* base, unsigned boff, const T& v) { *(T*)((char*)base + boff) = v; }
__device__ __forceinline__ float sum16b(const void* base, unsigned boff) { return (sum4(ldg<f32x4>(base, boff)) + sum4(ldg<f32x4>(base, boff + 16u))) + (sum4(ldg<f32x4>(base, boff + 32u)) + sum4(ldg<f32x4>(base, boff + 48u))); }
#define EPI_FENCE() do { asm volatile("" ::: "memory"); __builtin_amdgcn_sched_barrier(0); } while (0)


struct RowX  { const unsigned char* ssqx; struct Raw { f32x4 a; };
    __device__ __forceinline__ Raw load(const pg8::Unit& u, int t) const { return Raw{ldg<f32x4>(ssqx, (unsigned)(u.pm * 256 + t) * 16u)}; }
    __device__ __forceinline__ void fin(const Raw& r, LAS float* T, int t) const { T[t] = rsqrtf(sum4(r.a) * (1.0f / 1024.0f) + EPS); } };
struct RowQ  { const unsigned char* ssq1; struct Raw { f32x4 a, b; };
    __device__ __forceinline__ Raw load(const pg8::Unit& u, int t) const { const unsigned o = (unsigned)(u.pm * 256 + t) * 64u; return Raw{ldg<f32x4>(ssq1, o + 32u), ldg<f32x4>(ssq1, o + 48u)}; }
    __device__ __forceinline__ void fin(const Raw& r, LAS float* T, int t) const { T[t] = rsqrtf((sum4(r.a) + sum4(r.b)) * (1.0f / 384.0f) + EPS); } };
struct RowKV { const unsigned char* ssq1; bool use; struct Raw { f32x4 a; };
    __device__ __forceinline__ Raw load(const pg8::Unit& u, int t) const { return Raw{ldg<f32x4>(ssq1, (unsigned)(u.pm * 256 + t) * 64u)}; }
    __device__ __forceinline__ void fin(const Raw& r, LAS float* T, int t) const { T[t] = use ? rsqrtf(sum4(r.a) * (1.0f / 256.0f) + EPS) : 1.0f; } };
struct RowNone { struct Raw {}; __device__ __forceinline__ Raw load(const pg8::Unit&, int) const { return Raw{}; } __device__ __forceinline__ void fin(const Raw&, LAS float*, int) const {} };
struct ColNone { struct Raw {}; __device__ __forceinline__ Raw load(const pg8::Unit&, int) const { return Raw{}; } __device__ __forceinline__ void fin(const Raw&, LAS float*, int) const {} };
struct ColIn {
    const float* bias; const float* g_ckv; const float* g_sgu; const float* g_cq;
    struct Raw { float b, g; bool has; };
    __device__ __forceinline__ Raw load(const pg8::Unit& u, int c) const {
        const int T = u.pn; const bool has = (T == 3) || (T == 4) || (T == 6) || (T == 7 && c < 128);
        const float* gp = (T == 4) ? g_sgu + c : (T == 6) ? g_cq + c : (T == 7) ? g_cq + 256 + (c & 127) : g_ckv + c;
        return Raw{bias[modrow(u.pm) * 2048 + T * 256 + c], *gp, has}; }
    __device__ __forceinline__ void fin(const Raw& r, LAS float* T, int c) const { T[256 + c] = r.b; T[512 + c] = r.has ? r.g : 1.0f; }
};
struct ColRes {
    const float* gate; const float* gnext; const float* scnext;
    struct Raw { float g, n, s; };
    __device__ __forceinline__ Raw load(const pg8::Unit& u, int c) const { const int r = modrow(u.pm), col = u.pn * 256 + c; return Raw{gate[(size_t)r * NMOD + col], gnext[col], scnext[(size_t)r * NMOD + col]}; }
    __device__ __forceinline__ void fin(const Raw& r, LAS float* T, int c) const { T[256 + c] = r.g; T[512 + c] = r.n * (r.s + 1.0f); }
};
struct ColFF {
    const float* bias; const float* cw; const float* cb;
    struct Raw { float b, w0, w1, w2, c; };
    __device__ __forceinline__ Raw load(const pg8::Unit& u, int c) const { const int ch = u.pn * 128 + (c & 127), oc = (c < 128) ? ch : DFF + ch;
        return Raw{bias[(size_t)modrow(u.pm) * NFF + u.pn * 256 + c], cw[oc], cw[NFF + oc], cw[2 * NFF + oc], cb[oc]}; }
    __device__ __forceinline__ void fin(const Raw& r, LAS float* T, int c) const { T[256 + c] = r.b; T[512 + c] = r.w0; T[768 + c] = r.w1; T[1024 + c] = r.w2; T[1280 + c] = r.c; }
};
template <class RowFn, class ColFn> struct NextTab {
    typename RowFn::Raw rr; typename ColFn::Raw cr;
    __device__ __forceinline__ void load(const RowFn& rf, const ColFn& cf, const pg8::Unit& u, int t) { rr = rf.load(u, t & 255); cr = cf.load(u, t & 255); }
    __device__ __forceinline__ void store(const RowFn& rf, const ColFn& cf, LAS float* T, int t) const { rf.fin(rr, T, t & 255); cf.fin(cr, T, t & 255); }
};
#define EPI_TAB_END(nt, rf, cf, T, t) do { asm volatile("s_waitcnt lgkmcnt(0)\n\ts_barrier" ::: "memory"); (nt).store(rf, cf, T, t); } while (0)
__device__ __forceinline__ void tput4(LAS unsigned char* wscr, int m, const f32x4& v, int fr, int fq) {
    LAS unsigned short* s = (LAS unsigned short*)wscr + fq * 64 + 16 * m + fr;
    s[0] = (unsigned short)(cvtpk(v.x, 0.f) & 0xffffu); s[256] = (unsigned short)(cvtpk(v.y, 0.f) & 0xffffu); s[512] = (unsigned short)(cvtpk(v.z, 0.f) & 0xffffu); s[768] = (unsigned short)(cvtpk(v.w, 0.f) & 0xffffu);
}
template <int MODE = 0>
__device__ __forceinline__ void tflush(LAS unsigned char* wscr, bf16* VT, unsigned pitch, unsigned colbase, unsigned rowbase, int fr, int fq) {
    const unsigned lane = (unsigned)(fq * 16 + fr);
#pragma unroll
    for (int k = 0; k < 2; ++k) { const unsigned c = lane + 64u * k, j = c >> 5, f = (c >> 3) & 3u, ch = c & 7u;
        const v4u d = *(const LAS v4u*)(wscr + ((j * 4u + f) * 64u + 8u * ch) * 2u);
        const unsigned col = colbase + 8u * f + j, m8 = rowbase + 8u * ch;
        stg<v4u>(VT, (MODE == 1 ? vfrag_off(m8, col >> 6, col & 63u) : MODE == 2 ? vfrag8_off(m8, col >> 6, col & 63u) : col * pitch + m8) * 2u, d); }
}
struct EpiIn {
    static constexpr bool PERM = true, AFTER_DRAIN = false;
    int l; unsigned char* ws; float* out; LAS unsigned char* lds;
    RowX rowfn; ColIn colfn;


    template <int T> __device__ __forceinline__ void tile_tr(const f32x4 (&acc)[2][2][4][2], const pg8::Unit& u, int wr, int wc, int fr, int fq, const LAS float* tab) const {
        const int pm = u.pm; const bool ctx = pm < 16;
        const unsigned ct = (unsigned)(wc * 32 + 8 * fq);
        unsigned char* ssq1 = ws + WS_SSQ1;
        bf16* VT = (bf16*)(ws + (T == 2 ? WS_VTNA : WS_VTSGU));
        float* onv = out + OUT_NV + (size_t)(pm * 4 + l) * 65536;
        LAS unsigned char* wscr = lds + LDS_WSCR + (wr * 4 + wc) * 2048;
#pragma unroll
        for (int ai = 0; ai < 2; ++ai) {
            float ssm[4] = {0.f, 0.f, 0.f, 0.f}, rs4[4];
            const unsigned rowbase = (unsigned)(pm * 256 + ai * 128 + wr * 64);
#pragma unroll
            for (int m = 0; m < 4; ++m) rs4[m] = tab[ai * 128 + wr * 64 + m * 16 + fr];
#pragma unroll
            for (int bj = 0; bj < 2; ++bj)
#pragma unroll
                for (int n = 0; n < 2; ++n) {
                    EPI_FENCE();
                    const f32x4 bv = *(const LAS f32x4*)(tab + 256 + bj * 128 + ct + 4 * n), gv = *(const LAS f32x4*)(tab + 512 + bj * 128 + ct + 4 * n);
#pragma unroll
                    for (int m = 0; m < 4; ++m) {
                        f32x4 z = acc[ai][bj][m][n] * rs4[m] + bv;
                        if (T == 2) {
                            if (ctx) stg<f32x4>(onv, (((unsigned)(ai * 128 + wr * 64 + m * 16 + fr)) * 256u + bj * 128u + ct + 4u * n) * 4u, z);
                        } else {
#pragma unroll
                            for (int j = 0; j < 4; ++j) z[j] = gelu_tanh_f(z[j]);
                            ssm[m] += sq4(z);
                            z = z * gv;
                        }
                        tput4(wscr, m, z, fr, fq);
                    }
                    tflush<(T == 2) ? 1 : 0>(wscr, VT, (unsigned)MT, (unsigned)(bj * 128 + wc * 32 + 4 * n), rowbase, fr, fq);
                }
            if (T == 4) {
#pragma unroll
                for (int m = 0; m < 4; ++m) { float ss = xsum16(ssm[m]); ss = xsum32(ss); if (fq == 0) stg<float>(ssq1, ((rowbase + (unsigned)(m * 16 + fr)) * 16u + 4u + (unsigned)wc) * 4u, ss); }
            }
        }
    }
    template <int T> __device__ __forceinline__ void tile(const f32x4 (&acc)[2][2][4][2], const pg8::Unit& u, int wr, int wc, int fr, int fq, const LAS float* tab) const {
        const int pm = u.pm; const bool ctx = pm < 16;
        const unsigned ct = (unsigned)(wc * 32 + 8 * fq);
        const unsigned char* rope = ws + WS_ROPE;
        unsigned char* ssq1 = ws + WS_SSQ1;
        unsigned char* QNA = ws + WS_QNA; unsigned char* KNA = ws + WS_KNA; unsigned char* CKV = ws + WS_CKV; unsigned char* U = ws + WS_U; unsigned char* CQ = ws + WS_CQ; unsigned char* KR = ws + WS_KR;
        float* o_nk = out + OUT_NK + (size_t)(pm * 4 + l) * 65536; float* o_ckv = out + OUT_CKV + (size_t)(pm * 4 + l) * 65536; float* o_kr = out + OUT_KR + (size_t)(pm * 4 + l) * 8192;
#pragma unroll
        for (int ai = 0; ai < 2; ++ai)
#pragma unroll
            for (int m = 0; m < 4; ++m) {
                const unsigned row_t = (unsigned)(ai * 128 + wr * 64 + m * 16 + fr), row = (unsigned)pm * 256u + row_t;
                EPI_FENCE();
                f32x4 bv[2][2], gv[2][2];
#pragma unroll
                for (int bj = 0; bj < 2; ++bj)
#pragma unroll
                    for (int n = 0; n < 2; ++n) { bv[bj][n] = *(const LAS f32x4*)(tab + 256 + bj * 128 + ct + 4 * n); gv[bj][n] = *(const LAS f32x4*)(tab + 512 + bj * 128 + ct + 4 * n); }
                const float rstd = tab[row_t];
                f32x4 z[2][2];
#pragma unroll
                for (int bj = 0; bj < 2; ++bj)
#pragma unroll
                    for (int n = 0; n < 2; ++n) z[bj][n] = acc[ai][bj][m][n] * rstd + bv[bj][n];
                if (T == 0) {
#pragma unroll
                    for (int bj = 0; bj < 2; ++bj) stg<v4u>(QNA, (row * 256u + bj * 128u + ct) * 2u, pack8(z[bj][0] * QS_NA, z[bj][1] * QS_NA));
                } else if (T == 1) {
#pragma unroll
                    for (int bj = 0; bj < 2; ++bj) {
                        { const unsigned cc = bj * 128u + ct; stg<v4u>(KNA, kfrag_off(row, cc >> 6, (cc & 63u) >> 3) * 2u, pack8(z[bj][0], z[bj][1])); }
                        if (ctx) { const unsigned o = (row_t * 256u + bj * 128u + ct) * 4u; stg<f32x4>(o_nk, o, z[bj][0]); stg<f32x4>(o_nk, o + 16u, z[bj][1]); }
                    }
                } else if (T == 3) {
                    float ss = (sq4(z[0][0]) + sq4(z[0][1])) + (sq4(z[1][0]) + sq4(z[1][1]));
                    ss = xsum16(ss); ss = xsum32(ss);
                    if (fq == 0) stg<float>(ssq1, (row * 16u + 0u + (unsigned)wc) * 4u, ss);
#pragma unroll
                    for (int bj = 0; bj < 2; ++bj) {
                        const f32x4 v0 = z[bj][0] * gv[bj][0], v1 = z[bj][1] * gv[bj][1];
                        stg<v4u>(CKV, (row * 256u + bj * 128u + ct) * 2u, pack8(v0, v1));
                        if (ctx) { const unsigned o = (row_t * 256u + bj * 128u + ct) * 4u; stg<f32x4>(o_ckv, o, v0); stg<f32x4>(o_ckv, o + 16u, v1); }
                    }
                } else if (T == 5) {
#pragma unroll
                    for (int bj = 0; bj < 2; ++bj) {
#pragma unroll
                        for (int n = 0; n < 2; ++n)
#pragma unroll
                            for (int j = 0; j < 4; ++j) z[bj][n][j] = gelu_tanh_f(z[bj][n][j]);
                        stg<v4u>(U, (row * 256u + bj * 128u + ct) * 2u, pack8(z[bj][0], z[bj][1]));
                    }
                } else if (T == 6) {
                    float ss = (sq4(z[0][0]) + sq4(z[0][1])) + (sq4(z[1][0]) + sq4(z[1][1]));
                    ss = xsum16(ss); ss = xsum32(ss);
                    if (fq == 0) stg<float>(ssq1, (row * 16u + 8u + (unsigned)wc) * 4u, ss);
#pragma unroll
                    for (int bj = 0; bj < 2; ++bj) stg<v4u>(CQ, (row * 384u + bj * 128u + ct) * 2u, pack8(z[bj][0] * gv[bj][0], z[bj][1] * gv[bj][1]));
                } else {
                    float ss = sq4(z[0][0]) + sq4(z[0][1]);
                    ss = xsum16(ss); ss = xsum32(ss);
                    if (fq == 0) stg<float>(ssq1, (row * 16u + 12u + (unsigned)wc) * 4u, ss);
                    stg<v4u>(CQ, (row * 384u + 256u + ct) * 2u, pack8(z[0][0] * gv[0][0], z[0][1] * gv[0][1]));
                    if (wc == 0) {
                        const unsigned part = (unsigned)fq >> 1, i0 = 4u * ((unsigned)fq & 1u);
                        f32x4 x1 = z[1][0], x2 = z[1][1];
                        if (ctx) {
                            const unsigned o = (row_t * 32u + part * 16u + i0) * 4u;
                            stg<f32x4>(o_kr, o, x1); stg<f32x4>(o_kr, o + 32u, x2);
                        } else {
                            const unsigned t = (unsigned)((pm - 16) & 7) * 256u + row_t; const unsigned pos = part ? (t & 63u) : (t >> 6);
                            const f32x4 cs0 = ldg<f32x4>(rope, (pos * 8u + i0) * 8u), cs1 = ldg<f32x4>(rope, (pos * 8u + i0) * 8u + 16u);
                            const f32x4 c = {cs0.x, cs0.z, cs1.x, cs1.z}, s = {cs0.y, cs0.w, cs1.y, cs1.w};
                            const f32x4 o1 = x1 * c - x2 * s, o2 = x1 * s + x2 * c; x1 = o1; x2 = o2;
                        }
                        if (ctx) { unsigned char* KRF = ws + WS_KRF; stg<u32x2>(KRF, (krfrag_off(row, part, 0u) + i0) * 2u, pack4(x1)); stg<u32x2>(KRF, (krfrag_off(row, part, 1u) + i0) * 2u, pack4(x2)); }
                        else { stg<u32x2>(KR, (row * 32u + part * 16u + i0) * 2u, pack4(x1)); stg<u32x2>(KR, (row * 32u + part * 16u + 8u + i0) * 2u, pack4(x2)); }
                    }
                }
            }
    }
#ifndef TMASK
#define TMASK 0xFF
#endif
    __device__ __forceinline__ void prefill(const pg8::Unit& u, int wr, int wc, int fr, int fq) const { const int t = (wr * 4 + wc) * 64 + fq * 16 + fr; NextTab<RowX, ColIn> nt; nt.load(rowfn, colfn, u, t); nt.store(rowfn, colfn, (LAS float*)(lds + LDS_TAB), t); }
    __device__ __forceinline__ void operator()(const f32x4 (&acc)[2][2][4][2], const pg8::Unit& u, int wr, int wc, int fr, int fq, int, const pg8::Unit& nxt) const {
        LAS float* tab = (LAS float*)(lds + LDS_TAB); const int t = (wr * 4 + wc) * 64 + fq * 16 + fr;
        NextTab<RowX, ColIn> nt; nt.load(rowfn, colfn, nxt, t);
        switch (u.pn) {
            case 0: if (TMASK & 1) tile<0>(acc, u, wr, wc, fr, fq, tab); break;
            case 1: if (TMASK & 2) tile<1>(acc, u, wr, wc, fr, fq, tab); break;
            case 2: if (TMASK & 4) tile_tr<2>(acc, u, wr, wc, fr, fq, tab); break;
            case 3: if (TMASK & 8) tile<3>(acc, u, wr, wc, fr, fq, tab); break;
            case 4: if (TMASK & 16) tile_tr<4>(acc, u, wr, wc, fr, fq, tab); break;
            case 5: if (TMASK & 32) tile<5>(acc, u, wr, wc, fr, fq, tab); break;
            case 6: if (TMASK & 64) tile<6>(acc, u, wr, wc, fr, fq, tab); break;
            default: if (TMASK & 128) tile<7>(acc, u, wr, wc, fr, fq, tab); break;
        }
        EPI_TAB_END(nt, rowfn, colfn, tab, t);
    }
};

struct EpiQ {
    static constexpr bool PERM = true, AFTER_DRAIN = false;
    unsigned char* ws; LAS unsigned char* lds; RowQ rowfn;
    __device__ __forceinline__ void prefill(const pg8::Unit& u, int wr, int wc, int fr, int fq) const { const int t = (wr * 4 + wc) * 64 + fq * 16 + fr; NextTab<RowQ, ColNone> nt; nt.load(rowfn, ColNone(), u, t); nt.store(rowfn, ColNone(), (LAS float*)(lds + LDS_TAB), t); }
    __device__ __forceinline__ void operator()(const f32x4 (&acc)[2][2][4][2], const pg8::Unit& u, int wr, int wc, int fr, int fq, int, const pg8::Unit& nxt) const {
        const int pm = u.pm, pn = u.pn; const bool ctx = pm < 16; const unsigned ct = (unsigned)(wc * 32 + 8 * fq);
        LAS float* tab = (LAS float*)(lds + LDS_TAB); const int t = (wr * 4 + wc) * 64 + fq * 16 + fr;
        NextTab<RowQ, ColNone> nt; nt.load(rowfn, ColNone(), nxt, t); const unsigned char* rope = ws + WS_ROPE; unsigned char* QMLA = ws + WS_QMLA;
#pragma unroll
        for (int ai = 0; ai < 2; ++ai)
#pragma unroll
            for (int m = 0; m < 4; ++m) {
                const unsigned row_t = (unsigned)(ai * 128 + wr * 64 + m * 16 + fr), row = (unsigned)pm * 256u + row_t;
                EPI_FENCE();
                const float rs = tab[row_t] * QS_MLA;
                if (pn < 2) {
#pragma unroll
                    for (int bj = 0; bj < 2; ++bj) { const unsigned cc = (unsigned)(pn * 256 + bj * 128) + ct, h = cc >> 6, d = cc & 63u;
                        stg<v4u>(QMLA, (row * 768u + h * 96u + d) * 2u, pack8(acc[ai][bj][m][0] * rs, acc[ai][bj][m][1] * rs)); }
                } else {
                    const unsigned part = (unsigned)fq >> 1, i0 = 4u * ((unsigned)fq & 1u);
                    f32x4 c = {1.f, 1.f, 1.f, 1.f}, s = {0.f, 0.f, 0.f, 0.f};
                    if (!ctx) { const unsigned t = (unsigned)((pm - 16) & 7) * 256u + row_t; const unsigned pos = part ? (t & 63u) : (t >> 6);
                        const f32x4 cs0 = ldg<f32x4>(rope, (pos * 8u + i0) * 8u), cs1 = ldg<f32x4>(rope, (pos * 8u + i0) * 8u + 16u);
                        c = (f32x4){cs0.x, cs0.z, cs1.x, cs1.z}; s = (f32x4){cs0.y, cs0.w, cs1.y, cs1.w}; }
#pragma unroll
                    for (int bj = 0; bj < 2; ++bj) { const unsigned h = (unsigned)(bj * 4 + wc);
                        const f32x4 x1 = acc[ai][bj][m][0] * rs, x2 = acc[ai][bj][m][1] * rs;
                        const f32x4 o1 = x1 * c - x2 * s, o2 = x1 * s + x2 * c;
                        const unsigned dst = (row * 768u + h * 96u + 64u + part * 16u + i0) * 2u;
                        stg<u32x2>(QMLA, dst, pack4(o1)); stg<u32x2>(QMLA, dst + 16u, pack4(o2)); }
                }
            }
        EPI_TAB_END(nt, rowfn, ColNone(), tab, t);
    }
};

struct EpiKV {
    static constexpr bool PERM = true, AFTER_DRAIN = false;
    bf16* K; bf16* VT; int vtpitch; LAS unsigned char* lds; RowKV rowfn; bf16* KF; bf16* VF;
    __device__ __forceinline__ void prefill(const pg8::Unit& u, int wr, int wc, int fr, int fq) const { const int t = (wr * 4 + wc) * 64 + fq * 16 + fr; NextTab<RowKV, ColNone> nt; nt.load(rowfn, ColNone(), u, t); nt.store(rowfn, ColNone(), (LAS float*)(lds + LDS_TAB), t); }
    __device__ __forceinline__ void operator()(const f32x4 (&acc)[2][2][4][2], const pg8::Unit& u, int wr, int wc, int fr, int fq, int, const pg8::Unit& nxt) const {
        const int pm = u.pm, pn = u.pn; const unsigned ct = (unsigned)(wc * 32 + 8 * fq);
        LAS unsigned char* wscr = lds + LDS_WSCR + (wr * 4 + wc) * 2048;
        LAS float* tab = (LAS float*)(lds + LDS_TAB); const int t = (wr * 4 + wc) * 64 + fq * 16 + fr;
        NextTab<RowKV, ColNone> nt; nt.load(rowfn, ColNone(), nxt, t);
#pragma unroll
        for (int ai = 0; ai < 2; ++ai) {
            float rs[4];
#pragma unroll
            for (int m = 0; m < 4; ++m) rs[m] = tab[ai * 128 + wr * 64 + m * 16 + fr];
            if (pn < 2) {
#pragma unroll
                for (int m = 0; m < 4; ++m) {
                    const unsigned row = (unsigned)(pm * 256 + ai * 128 + wr * 64 + m * 16 + fr);
                    EPI_FENCE();
#pragma unroll
                    for (int bj = 0; bj < 2; ++bj) { const unsigned cc = (unsigned)(pn * 256 + bj * 128) + ct; const v4u w = pack8(acc[ai][bj][m][0] * rs[m], acc[ai][bj][m][1] * rs[m]);
                        if (KF && pm < 16) stg<v4u>(KF, kfrag8_off(row, cc >> 6, (cc & 63u) >> 3) * 2u, w); else stg<v4u>(K, (row * 512u + cc) * 2u, w); }
                }
            } else {
                const unsigned rowbase = (unsigned)(pm * 256 + ai * 128 + wr * 64);
#pragma unroll
                for (int bj = 0; bj < 2; ++bj)
#pragma unroll
                    for (int n = 0; n < 2; ++n) {
                        EPI_FENCE();
#pragma unroll
                        for (int m = 0; m < 4; ++m) tput4(wscr, m, acc[ai][bj][m][n] * rs[m], fr, fq);
                        if (VF && pm < 16) tflush<2>(wscr, VF, 0u, (unsigned)((pn - 2) * 256 + bj * 128 + wc * 32 + 4 * n), rowbase, fr, fq);
                        else tflush<0>(wscr, VT, (unsigned)vtpitch, (unsigned)((pn - 2) * 256 + bj * 128 + wc * 32 + 4 * n), rowbase, fr, fq);
                    }
            }
        }
        EPI_TAB_END(nt, rowfn, ColNone(), tab, t);
    }
};

template <bool PART>
struct EpiRes {
    static constexpr bool PERM = true, AFTER_DRAIN = false;
    bf16* xr; bf16* XA; float* ssqx; LAS unsigned char* lds; ColRes colfn; const float* pslot; unsigned* pflag;
    __device__ __forceinline__ void prefill(const pg8::Unit& u, int wr, int wc, int fr, int fq) const { const int t = (wr * 4 + wc) * 64 + fq * 16 + fr; NextTab<RowNone, ColRes> nt; nt.load(RowNone(), colfn, u, t); nt.store(RowNone(), colfn, (LAS float*)(lds + LDS_TAB), t); }
    __device__ __forceinline__ void operator()(const f32x4 (&acc)[2][2][4][2], const pg8::Unit& u, int wr, int wc, int fr, int fq, int, const pg8::Unit& nxt) const {
        const int pm = u.pm, pn = u.pn; const unsigned ct = (unsigned)(pn * 256 + wc * 32 + 8 * fq);
        LAS float* tab = (LAS float*)(lds + LDS_TAB); const int t = (wr * 4 + wc) * 64 + fq * 16 + fr;
        NextTab<RowNone, ColRes> nt; nt.load(RowNone(), colfn, nxt, t);
        const unsigned cl = (unsigned)(wc * 32 + 8 * fq);
        __amdgpu_buffer_rsrc_t prs = __builtin_amdgcn_make_buffer_rsrc((void*)(PART ? (const void*)pslot : (const void*)xr), 0, 131072, 0x00020000); const unsigned po = (unsigned)t * 16u;
        if constexpr (PART) {
            if (t == 0) { unsigned sp = 0; while (__hip_atomic_load(pflag, __ATOMIC_RELAXED, __HIP_MEMORY_SCOPE_AGENT) == 0u) { __builtin_amdgcn_s_sleep(1); if (++sp > (1u << 22)) break; } asm volatile("s_waitcnt vmcnt(0)" ::: "memory"); }
            __builtin_amdgcn_s_barrier();
        }
        LAS float* SS = (LAS float*)(lds + LDS_WSCR);
#pragma unroll
        for (int ai = 0; ai < 2; ++ai) {
            EPI_FENCE();
            v4u xb[4][2];
#pragma unroll
            for (int m = 0; m < 4; ++m)
#pragma unroll
                for (int bj = 0; bj < 2; ++bj) xb[m][bj] = ldg<v4u>(xr, ((unsigned)(pm * 256 + ai * 128 + wr * 64 + m * 16 + fr) * (unsigned)DM + ct + bj * 128u) * 2u);
            pg8::sk_u64x2 pb[4][2];
            if constexpr (PART) {
#pragma unroll
                for (int m = 0; m < 4; ++m)
#pragma unroll
                    for (int bj = 0; bj < 2; ++bj) pb[m][bj] = __builtin_bit_cast(pg8::sk_u64x2, __builtin_amdgcn_raw_buffer_load_b128(prs, po + (unsigned)((ai * 2 + bj) * 4 + m) * 8192u, 0,   16));
            }
#pragma unroll
            for (int m = 0; m < 4; ++m) {
                const unsigned row = (unsigned)(pm * 256 + ai * 128 + wr * 64 + m * 16 + fr);
                float ss = 0.f;
#pragma unroll
                for (int bj = 0; bj < 2; ++bj) {
                    EPI_FENCE();
                    const unsigned col = ct + bj * 128u, o = (row * (unsigned)DM + col) * 2u;
                    const f32x4 g0 = *(const LAS f32x4*)(tab + 256 + bj * 128 + cl), g1 = *(const LAS f32x4*)(tab + 256 + bj * 128 + cl + 4);
                    f32x4 a0 = acc[ai][bj][m][0], a1 = acc[ai][bj][m][1];
                    if constexpr (PART) { a0 += pg8::sk_unpack(pb[m][bj].x); a1 += pg8::sk_unpack(pb[m][bj].y); }
                    const v4u xw = xb[m][bj];
                    const f32x4 x0 = (f32x4){hlo(xw.x), hhi(xw.x), hlo(xw.y), hhi(xw.y)} + g0 * a0;
                    const f32x4 x1 = (f32x4){hlo(xw.z), hhi(xw.z), hlo(xw.w), hhi(xw.w)} + g1 * a1;
                    { v4u w; w.x = cvtpkh(x0.x, x0.y); w.y = cvtpkh(x0.z, x0.w); w.z = cvtpkh(x1.x, x1.y); w.w = cvtpkh(x1.z, x1.w); stg<v4u>(xr, o, w); }
                    ss += sq4(x0) + sq4(x1);
                    if (XA) { const f32x4 s0 = *(const LAS f32x4*)(tab + 512 + bj * 128 + cl), s1 = *(const LAS f32x4*)(tab + 512 + bj * 128 + cl + 4);
                        stg<v4u>(XA, o, pack8(x0 * s0, x1 * s1)); }
                }
                ss = xsum16(ss); ss = xsum32(ss);
                if (fq == 0) SS[wc * 256 + ai * 128 + wr * 64 + m * 16 + fr] = ss;
            }
        }
        EPI_TAB_END(nt, RowNone(), colfn, tab, t);
        if (t < 256) stg<float>(ssqx, ((unsigned)(pm * 256 + t) * 4u + (unsigned)pn) * 4u, (SS[t] + SS[256 + t]) + (SS[512 + t] + SS[768 + t]));
    }
};

template <int CTRL> __device__ __forceinline__ f32x4 dpp4(const f32x4& v) { return (f32x4){dpp_f<CTRL>(v.x), dpp_f<CTRL>(v.y), dpp_f<CTRL>(v.z), dpp_f<CTRL>(v.w)}; }
template <int CTRL> __device__ __forceinline__ f32x4 dppk4(const f32x4& old, const f32x4& v) { return (f32x4){dpp_keep_f<CTRL>(old.x, v.x), dpp_keep_f<CTRL>(old.y, v.y), dpp_keep_f<CTRL>(old.z, v.z), dpp_keep_f<CTRL>(old.w, v.w)}; }
__device__ __forceinline__ f32x4 sel4(bool c, const f32x4& a, const f32x4& b) { return (f32x4){c ? a.x : b.x, c ? a.y : b.y, c ? a.z : b.z, c ? a.w : b.w}; }
struct EpiFF1 {
    static constexpr bool PERM = true, AFTER_DRAIN = false;
    bf16* ACT; float* EDGE_A; float* EDGE_P; LAS unsigned char* lds; RowX rowfn; ColFF colfn;
    __device__ __forceinline__ void prefill(const pg8::Unit& u, int wr, int wc, int fr, int fq) const { const int t = (wr * 4 + wc) * 64 + fq * 16 + fr; NextTab<RowX, ColFF> nt; nt.load(rowfn, colfn, u, t); nt.store(rowfn, colfn, (LAS float*)(lds + LDS_TAB), t); }
    __device__ __forceinline__ void operator()(f32x4 (&acc)[2][2][4][2], const pg8::Unit& u, int wr, int wc, int fr, int fq, int, const pg8::Unit& nxt) const {
        const int pm = u.pm, pn = u.pn; const int wave = wr * 4 + wc; const unsigned cl = (unsigned)(wc * 32 + 8 * fq);
        LAS float* T = (LAS float*)(lds + LDS_TAB);
        LAS float* XB = (LAS float*)(lds + LDS_WSCR);
        const int t = wave * 64 + fq * 16 + fr;
        NextTab<RowX, ColFF> nt; nt.load(rowfn, colfn, nxt, t);
#pragma unroll
        for (int ai = 0; ai < 2; ++ai)
#pragma unroll
            for (int m = 0; m < 4; ++m) { const float rs = T[ai * 128 + wr * 64 + m * 16 + fr];
#pragma unroll
                for (int bj = 0; bj < 2; ++bj)
#pragma unroll
                    for (int n = 0; n < 2; ++n) acc[ai][bj][m][n] = acc[ai][bj][m][n] * rs + *(const LAS f32x4*)(T + 256 + bj * 128 + cl + 4 * n); }
#pragma unroll
        for (int ai = 0; ai < 2; ++ai)
#pragma unroll
            for (int bj = 0; bj < 2; ++bj)
#pragma unroll
                for (int n = 0; n < 2; ++n) {
                    if (fr == 0) *(LAS f32x4*)(XB + ((wave * 2 + ai) * 2 + 0) * 64 + fq * 16 + bj * 8 + n * 4) = acc[ai][bj][0][n];
                    if (fr == 15) *(LAS f32x4*)(XB + ((wave * 2 + ai) * 2 + 1) * 64 + fq * 16 + bj * 8 + n * 4) = acc[ai][bj][3][n];
                }
        if (wr == 0 && fr == 0) {
#pragma unroll
            for (int bj = 0; bj < 2; ++bj)
#pragma unroll
                for (int n = 0; n < 2; ++n) stg<f32x4>(EDGE_A, (((unsigned)pm * 2u + 0u) * (unsigned)NFF + (unsigned)(pn * 256 + bj * 128) + cl + 4u * n) * 4u, acc[0][bj][0][n]);
        }
        if (wr == 1 && fr == 15) {
#pragma unroll
            for (int bj = 0; bj < 2; ++bj)
#pragma unroll
                for (int n = 0; n < 2; ++n) stg<f32x4>(EDGE_A, (((unsigned)pm * 2u + 1u) * (unsigned)NFF + (unsigned)(pn * 256 + bj * 128) + cl + 4u * n) * 4u, acc[1][bj][3][n]);
        }
        asm volatile("s_waitcnt lgkmcnt(0)\n\ts_barrier" ::: "memory");
        const int pw = wave ^ 4;
        const f32x4 zero4 = {0.f, 0.f, 0.f, 0.f};
#pragma unroll
        for (int ai = 0; ai < 2; ++ai)
#pragma unroll
            for (int n = 0; n < 2; ++n) {
                EPI_FENCE();
                f32x4 hu[2], hd[2];
#pragma unroll
                for (int bj = 0; bj < 2; ++bj) {
                    const int o = fq * 16 + bj * 8 + n * 4;
                    if (wr == 0) { hu[bj] = (ai == 0) ? zero4 : *(const LAS f32x4*)(XB + ((pw * 2 + 0) * 2 + 1) * 64 + o); hd[bj] = *(const LAS f32x4*)(XB + ((pw * 2 + ai) * 2 + 0) * 64 + o); }
                    else { hu[bj] = *(const LAS f32x4*)(XB + ((pw * 2 + ai) * 2 + 1) * 64 + o); hd[bj] = (ai == 1) ? zero4 : *(const LAS f32x4*)(XB + ((pw * 2 + 1) * 2 + 0) * 64 + o); }
                }
#pragma unroll
                for (int m = 0; m < 4; ++m) {
                    const unsigned row_t = (unsigned)(ai * 128 + wr * 64 + m * 16 + fr), row = (unsigned)(pm * 256) + row_t;
                    f32x4 cv[2];
#pragma unroll
                    for (int bj = 0; bj < 2; ++bj) {
                        const f32x4 X = acc[ai][bj][m][n];
                        const f32x4 upn = (m > 0) ? dpp4<0x121>(acc[ai][bj][m > 0 ? m - 1 : 0][n]) : hu[bj];
                        const f32x4 dnn = (m < 3) ? dpp4<0x12F>(acc[ai][bj][m < 3 ? m + 1 : 3][n]) : hd[bj];
                        const f32x4 up = dppk4<0x111>(upn, X), dn = dppk4<0x101>(dnn, X);
                        const int c = bj * 128 + (int)cl + 4 * n;
                        cv[bj] = *(const LAS f32x4*)(T + 512 + c) * up + *(const LAS f32x4*)(T + 768 + c) * X + *(const LAS f32x4*)(T + 1024 + c) * dn + *(const LAS f32x4*)(T + 1280 + c);
                    }
                    if ((ai == 0 && m == 0 && wr == 0 && fr == 0) || (ai == 1 && m == 3 && wr == 1 && fr == 15)) {
                        const unsigned e = (row_t == 0u) ? 0u : 1u;
#pragma unroll
                        for (int bj = 0; bj < 2; ++bj) stg<f32x4>(EDGE_P, (((unsigned)pm * 2u + e) * (unsigned)NFF + (unsigned)(pn * 256 + bj * 128) + cl + 4u * n) * 4u, cv[bj]);
                    }
                    const f32x4 o = {silu_f(cv[0].x) * cv[1].x, silu_f(cv[0].y) * cv[1].y, silu_f(cv[0].z) * cv[1].z, silu_f(cv[0].w) * cv[1].w};
                    stg<u32x2>(ACT, (row * (unsigned)DFF + (unsigned)(pn * 128) + cl + 4u * n) * 2u, pack4(o));
                }
            }
        EPI_TAB_END(nt, rowfn, colfn, T, t);
    }
};
__device__ __forceinline__ void conv_fixup(int pm, bf16* ACT, const float* EDGE_A, const float* EDGE_P, const float* cw, int tid) {
    if (pm < 16) return;
    const int kq = (pm - 16) & 7;
    for (int ch = tid; ch < DFF; ch += NTHR) {
        const int gi = (ch >> 7) * 256 + (ch & 127), vi = gi + 128;
        if (kq > 0) { const float* P = EDGE_P + (size_t)(pm * 2 + 0) * NFF; const float* A = EDGE_A + (size_t)((pm - 1) * 2 + 1) * NFF;
            const float g = P[gi] + cw[ch] * A[gi], v = P[vi] + cw[DFF + ch] * A[vi];
            ACT[(size_t)(pm * 256) * DFF + ch] = (bf16)(cvtpk(silu_f(g) * v, 0.f) & 0xffffu); }
        if (kq < 7) { const float* P = EDGE_P + (size_t)(pm * 2 + 1) * NFF; const float* A = EDGE_A + (size_t)((pm + 1) * 2 + 0) * NFF;
            const float g = P[gi] + cw[2 * NFF + ch] * A[gi], v = P[vi] + cw[2 * NFF + DFF + ch] * A[vi];
            ACT[(size_t)(pm * 256 + 255) * DFF + ch] = (bf16)(cvtpk(silu_f(g) * v, 0.f) & 0xffffu); }
    }
}


__device__ __forceinline__ f32x16 mfma32(bf16x8 a, bf16x8 b, f32x16 c) { return __builtin_amdgcn_mfma_f32_32x32x16_bf16(a, b, c, 0, 0, 0); }
__device__ __forceinline__ bf16x8 ld8(const bf16* p) { return *(const bf16x8*)p; }

struct NoMod { __device__ __forceinline__ void operator()(f32x16&) const {} };
struct NaMod {
    const LAS float* rpb; int c, cs, kc0; bool en;
    __device__ __forceinline__ void operator()(f32x16& S) const {
        if (!en) return;
#pragma unroll
        for (int s = 0; s < 2; ++s)
#pragma unroll
            for (int j = 0; j < 8; ++j) { const int kc = kc0 + 16 * s + j; const bool ok = (unsigned)(kc - cs) < 16u;
                int co = kc - c; co = co < -15 ? -15 : (co > 15 ? 15 : co);
                const float b = rpb[co + 15];
                S[8 * s + j] = ok ? S[8 * s + j] + b : NEG_BIG; }
    }
};

template <int DK> struct KVF { bf16x8 kf[DK / 16]; bf16x8 vf[2][2]; };
template <int DK>
__device__ __forceinline__ void kv_load(KVF<DK>& f, const bf16* Krow, const bf16* KRrow, const bf16* VTp, size_t vtpitch) {
#pragma unroll
    for (int d0 = 0; d0 < 4; ++d0) f.kf[d0] = ld8(Krow + 16 * d0);
    if constexpr (DK == 96) { f.kf[4] = ld8(KRrow); f.kf[5] = ld8(KRrow + 16); }
#pragma unroll
    for (int blk = 0; blk < 2; ++blk)
#pragma unroll
        for (int s = 0; s < 2; ++s) f.vf[blk][s] = ld8(VTp + (size_t)(32 * blk) * vtpitch + 16 * s);
}
struct CZero { __device__ __forceinline__ void operator()(f32x16& S) const {
#pragma unroll
    for (int i = 0; i < 16; ++i) S[i] = 0.f; } };
struct CBias { f32x4 b[4];
    __device__ __forceinline__ void operator()(f32x16& S) const {
#pragma unroll
        for (int i = 0; i < 4; ++i) { S[i] = b[0][i]; S[4 + i] = b[1][i]; S[8 + i] = b[2][i]; S[12 + i] = b[3][i]; } } };
__device__ __forceinline__ void kv_load_frag(KVF<64>& f, const bf16* Kblk, const bf16* Vblk, int lane) {
#pragma unroll
    for (int d0 = 0; d0 < 4; ++d0) f.kf[d0] = ld8(Kblk + d0 * 512 + lane * 8);
#pragma unroll
    for (int blk = 0; blk < 2; ++blk)
#pragma unroll
        for (int s = 0; s < 2; ++s) f.vf[blk][s] = ld8(Vblk + (blk * 2 + s) * 512 + lane * 8);
}
template <int DK, class Mod, class CInit = CZero>
__device__ __forceinline__ void attn_compute(const KVF<DK>& f, const bf16x8 (&q)[DK / 16], f32x16 (&o)[2], float& m, float& l, const Mod& mod, const CInit& ci = CInit()) {
    f32x16 S;
    ci(S);
#pragma unroll
    for (int d0 = 0; d0 < DK / 16; ++d0) S = mfma32(f.kf[d0], q[d0], S);
    mod(S);
    float mx = S[0];
#pragma unroll
    for (int i = 1; i < 16; ++i) mx = fmaxf(mx, S[i]);
    mx = xmax32(mx);
    if (__any(mx > m)) {
        const float mn = fmaxf(m, mx), alpha = fast_exp2(m - mn); m = mn; l *= alpha;
#pragma unroll
        for (int i = 0; i < 16; ++i) { o[0][i] *= alpha; o[1][i] *= alpha; }
    }
    float ps = 0.f;
#pragma unroll
    for (int i = 0; i < 16; ++i) { S[i] = fast_exp2(S[i] - m); ps += S[i]; }
    l += ps;
    v4u p0, p1;
    p0.x = cvtpk(S[0], S[1]); p0.y = cvtpk(S[2], S[3]); p0.z = cvtpk(S[4], S[5]); p0.w = cvtpk(S[6], S[7]);
    p1.x = cvtpk(S[8], S[9]); p1.y = cvtpk(S[10], S[11]); p1.z = cvtpk(S[12], S[13]); p1.w = cvtpk(S[14], S[15]);
    const bf16x8 pb0 = __builtin_bit_cast(bf16x8, p0), pb1 = __builtin_bit_cast(bf16x8, p1);
    o[0] = mfma32(f.vf[0][0], pb0, o[0]); o[0] = mfma32(f.vf[0][1], pb1, o[0]);
    o[1] = mfma32(f.vf[1][0], pb0, o[1]); o[1] = mfma32(f.vf[1][1], pb1, o[1]);
}
__device__ __forceinline__ void attn_store(const f32x16 (&o)[2], float l, bf16* dst, int hi) {
    const float lt = xsum32(l); const float inv = 1.0f / lt;
#pragma unroll
    for (int blk = 0; blk < 2; ++blk)
#pragma unroll
        for (int g = 0; g < 4; ++g) { const f32x4 v = {o[blk][4 * g] * inv, o[blk][4 * g + 1] * inv, o[blk][4 * g + 2] * inv, o[blk][4 * g + 3] * inv};
            *(u32x2*)(dst + 32 * blk + 8 * g + 4 * hi) = pack4(v); }
}

struct P3Ptrs {
    unsigned char* ws; int l; const float* b_sgu;
    __device__ __forceinline__ const bf16* p(size_t off) const { return (const bf16*)(ws + off); }
};
#define P3_QNA P.p(WS_QNA)
#define P3_KNA P.p(WS_KNA)
#define P3_VTNA P.p(WS_VTNA)
#define P3_KCNA (P.p(WS_KCNA) + (size_t)P.l * 1024 * 256)
#define P3_VTCNA (P.p(WS_VTCNA) + (size_t)P.l * 256 * 1024)
#define P3_QMLA P.p(WS_QMLA)
#define P3_KMLA P.p(WS_KMLA)
#define P3_KR P.p(WS_KR)
#define P3_VTMLA P.p(WS_VTMLA)
#define P3_KCMLA (P.p(WS_KCMLA) + (size_t)P.l * 1024 * 512)
#define P3_KRC (P.p(WS_KRC) + (size_t)P.l * 1024 * 32)
#define P3_VTCMLA (P.p(WS_VTCMLA) + (size_t)P.l * 512 * 1024)
#define P3_U P.p(WS_U)
#define P3_VTSGU P.p(WS_VTSGU)
#define P3_WSGU (P.p(WS_WSGU) + (size_t)P.l * 4 * 128 * 128)
#define P3_RSV ((const float*)(P.ws + WS_RSV))
#define P3_MIX ((bf16*)(P.ws + WS_MIX))

constexpr int MLA_KT_PITCH = 104, MLA_VT_PITCH = 72, MLA_KT_BYTES = 64 * MLA_KT_PITCH * 2, MLA_BUF_BYTES = MLA_KT_BYTES + 64 * MLA_VT_PITCH * 2;
__device__ __forceinline__ void unit_mla_lat_wg(const P3Ptrs& P, int u, int wave, int lane, LAS unsigned char* lds) {
    const int r32 = lane & 31, hi = lane >> 5, kap = (r32 & ~12) | ((r32 & 8) >> 1) | ((r32 & 4) << 1);
    const int qb8 = u & 7, h = (u >> 3) & 7, b = u >> 6;
    const size_t mq = (size_t)NCTX + (size_t)b * 2048 + 256 * qb8 + 32 * wave + r32;
    bf16x8 q[6];
#pragma unroll
    for (int d0 = 0; d0 < 6; ++d0) q[d0] = ld8(P3_QMLA + mq * 768 + h * 96 + 16 * d0 + 8 * hi);
    f32x16 o[2];
#pragma unroll
    for (int i = 0; i < 16; ++i) { o[0][i] = 0.f; o[1][i] = 0.f; }
    float mref = 0.f, l = 0.f; bool first = true;
    f32x16 negm;
#pragma unroll
    for (int i = 0; i < 16; ++i) negm[i] = 0.f;
    const int t = wave * 64 + lane;
    const int kkey = t >> 3, kc = t & 7, rkey = (t & 255) >> 2, rc = t & 3;
    const unsigned wK = (unsigned)(kkey * MLA_KT_PITCH + 8 * kc) * 2u, wR = (unsigned)(rkey * MLA_KT_PITCH + 64 + 8 * rc) * 2u, wV = (unsigned)MLA_KT_BYTES + (unsigned)(kkey * MLA_VT_PITCH + 8 * kc) * 2u;
    const unsigned rK = (unsigned)(kap * MLA_KT_PITCH + 8 * hi) * 2u, rV = (unsigned)MLA_KT_BYTES + (unsigned)(r32 * MLA_VT_PITCH + 8 * hi) * 2u;
    const size_t mk = (size_t)NCTX + (size_t)b * 2048;
    const char* KCb = (const char*)(P3_KCMLA + (size_t)(b * 256) * 512 + h * 64);
    const char* RCb = (const char*)(P3_KRC + (size_t)(b * 256) * 32);
    const char* VCb = (const char*)(P3_VTCMLA + (size_t)(h * 64) * 1024 + b * 256);
    const char* KLb = (const char*)(P3_KMLA + mk * 512 + h * 64);
    const char* RLb = (const char*)(P3_KR + mk * 32);
    const char* VLb = (const char*)(P3_VTMLA + (size_t)(h * 64) * MT + mk);
    const unsigned oK = (unsigned)(kkey * 512 + 8 * kc) * 2u, oR = (unsigned)(rkey * 32 + 8 * rc) * 2u, oVc = (unsigned)(kkey * 1024 + 8 * kc) * 2u, oVl = (unsigned)(kkey * MT + 8 * kc) * 2u;
    v4u xk, xr = {0u, 0u, 0u, 0u}, xv, yk, yr = {0u, 0u, 0u, 0u}, yv;
#define MLA_FETCH(gk, gr, gv, tile) do { const bool cx_ = (tile) < 4; const size_t tt_ = cx_ ? (size_t)(tile) : (size_t)((tile) - 4); \
        const char* kb_ = (cx_ ? KCb : KLb) + tt_ * (64 * 512 * 2); const char* rb_ = (cx_ ? RCb : RLb) + tt_ * (64 * 32 * 2); const char* vb_ = (cx_ ? VCb : VLb) + tt_ * (64 * 2); \
        gk = *(const v4u*)(kb_ + oK); gr = *(const v4u*)(rb_ + oR); gv = *(const v4u*)(vb_ + (cx_ ? oVc : oVl)); } while (0)
#define MLA_PUT(gk, gr, gv, buf) do { LAS unsigned char* bp_ = lds + (buf) * MLA_BUF_BYTES; *(LAS v4u*)(bp_ + wK) = gk; *(LAS v4u*)(bp_ + wR) = gr; *(LAS v4u*)(bp_ + wV) = gv; } while (0)
#ifndef MLA_PROBE
#define MLA_PROBE 0
#endif
#if MLA_PROBE == 1
#define MLA_PROBE_VALU() do { float dd_ = 0.f; _Pragma("unroll") for (int i = 0; i < 16; ++i) { dd_ += fast_exp2(S0[i] * 0.5f - mref) + fast_exp2(S1[i] * 0.5f - mref); } asm volatile("" :: "v"(dd_)); } while (0)
#else
#define MLA_PROBE_VALU() do {} while (0)
#endif
#if MLA_PROBE == 2
#define MLA_PROBE_MFMA() do { f32x16 dm_; _Pragma("unroll") for (int i = 0; i < 16; ++i) dm_[i] = 0.f; _Pragma("unroll") for (int d0 = 0; d0 < 4; ++d0) { dm_ = mfma32(kf[0][d0], q[d0 + 1], dm_); dm_ = mfma32(kf[1][d0], q[d0 + 2], dm_); } asm volatile("" :: "v"(dm_)); } while (0)
#else
#define MLA_PROBE_MFMA() do {} while (0)
#endif
#define MLA_TILE(buf) do { \
        const LAS unsigned char* bp = lds + (buf) * MLA_BUF_BYTES; \
        bf16x8 kf[2][6]; \
        _Pragma("unroll") for (int d0 = 0; d0 < 6; ++d0) { kf[0][d0] = *(const LAS bf16x8*)(bp + rK + d0 * 32); kf[1][d0] = *(const LAS bf16x8*)(bp + rK + 32 * MLA_KT_PITCH * 2 + d0 * 32); } \
        __builtin_amdgcn_sched_barrier(0); \
        f32x16 S0 = mfma32(kf[0][0], q[0], negm), S1 = mfma32(kf[1][0], q[0], negm);     \
        _Pragma("unroll") for (int d0 = 1; d0 < 6; ++d0) { S0 = mfma32(kf[0][d0], q[d0], S0); S1 = mfma32(kf[1][d0], q[d0], S1); } \
        bf16x8 vf[2][4]; \
        _Pragma("unroll") for (int blk = 0; blk < 2; ++blk) _Pragma("unroll") for (int s = 0; s < 4; ++s) vf[blk][s] = *(const LAS bf16x8*)(bp + rV + blk * 32 * MLA_VT_PITCH * 2 + s * 32); \
        __builtin_amdgcn_sched_barrier(0); \
        float mx = fmaxf(S0[0], S1[0]); \
        _Pragma("unroll") for (int i = 1; i < 16; ++i) mx = fmaxf(fmaxf(S0[i], S1[i]), mx); \
        mx = xmax32(mx); \
        if (first || __any(mx > 8.0f)) {     \
            const float dl = first ? mx : fmaxf(mx, 0.f), alpha = fast_exp2(-dl); mref += dl; l *= alpha; first = false; \
            _Pragma("unroll") for (int i = 0; i < 16; ++i) { o[0][i] *= alpha; o[1][i] *= alpha; S0[i] -= dl; S1[i] -= dl; negm[i] = -mref; } } \
        float ps = 0.f; \
        _Pragma("unroll") for (int i = 0; i < 16; ++i) { S0[i] = fast_exp2(S0[i]); S1[i] = fast_exp2(S1[i]); ps += S0[i] + S1[i]; } \
        l += ps; \
        MLA_PROBE_VALU(); MLA_PROBE_MFMA(); \
        v4u p0, p1, p2, p3; \
        p0.x = cvtpk(S0[0], S0[1]); p0.y = cvtpk(S0[2], S0[3]); p0.z = cvtpk(S0[4], S0[5]); p0.w = cvtpk(S0[6], S0[7]); \
        p1.x = cvtpk(S0[8], S0[9]); p1.y = cvtpk(S0[10], S0[11]); p1.z = cvtpk(S0[12], S0[13]); p1.w = cvtpk(S0[14], S0[15]); \
        p2.x = cvtpk(S1[0], S1[1]); p2.y = cvtpk(S1[2], S1[3]); p2.z = cvtpk(S1[4], S1[5]); p2.w = cvtpk(S1[6], S1[7]); \
        p3.x = cvtpk(S1[8], S1[9]); p3.y = cvtpk(S1[10], S1[11]); p3.z = cvtpk(S1[12], S1[13]); p3.w = cvtpk(S1[14], S1[15]); \
        const bf16x8 pb0 = __builtin_bit_cast(bf16x8, p0), pb1 = __builtin_bit_cast(bf16x8, p1), pb2 = __builtin_bit_cast(bf16x8, p2), pb3 = __builtin_bit_cast(bf16x8, p3); \
        _Pragma("unroll") for (int blk = 0; blk < 2; ++blk) { o[blk] = mfma32(vf[blk][0], pb0, o[blk]); o[blk] = mfma32(vf[blk][1], pb1, o[blk]); o[blk] = mfma32(vf[blk][2], pb2, o[blk]); o[blk] = mfma32(vf[blk][3], pb3, o[blk]); } \
    } while (0)
    MLA_FETCH(xk, xr, xv, 0); MLA_PUT(xk, xr, xv, 0);
    MLA_FETCH(xk, xr, xv, 1); MLA_FETCH(yk, yr, yv, 2);
    __syncthreads();
#pragma unroll 1
    for (int tile = 0; tile < 36; tile += 2) {
        MLA_TILE(0);
        MLA_PUT(xk, xr, xv, 1);
        MLA_FETCH(xk, xr, xv, tile + 3 < 36 ? tile + 3 : 35);
        __syncthreads();
        MLA_TILE(1);
        if (tile + 2 < 36) MLA_PUT(yk, yr, yv, 0);
        MLA_FETCH(yk, yr, yv, tile + 4 < 36 ? tile + 4 : 35);
        __syncthreads();
    }
#undef MLA_FETCH
#undef MLA_PUT
#undef MLA_TILE
    attn_store(o, l, P3_MIX + mq * 1024 + 256 + h * 64, hi);
}
__device__ __forceinline__ void unit_mla_ctx(const P3Ptrs& P, int u, int lane) {
    const int r32 = lane & 31, hi = lane >> 5, kap = (r32 & ~12) | ((r32 & 8) >> 1) | ((r32 & 4) << 1);
    const int qb = u & 7, h = (u >> 3) & 7, b = u >> 6;
    const size_t mq = (size_t)b * 256 + 32 * qb + r32, mk = (size_t)b * 256;
    bf16x8 q[6];
#pragma unroll
    for (int d0 = 0; d0 < 6; ++d0) q[d0] = ld8(P3_QMLA + mq * 768 + h * 96 + 16 * d0 + 8 * hi);
    f32x16 o[2];
#pragma unroll
    for (int i = 0; i < 16; ++i) { o[0][i] = 0.f; o[1][i] = 0.f; }
    float m = NEG_BIG, l = 0.f;
    const bf16* Kb = P3_KMLA + ((size_t)(mk >> 5) * 8 + h) * 2048 + lane * 8;
    const bf16* Rb = (const bf16*)(P.ws + WS_KRF) + (size_t)(mk >> 5) * 1024 + lane * 8;
    const bf16* Vb = (const bf16*)(P.ws + WS_VFM) + ((size_t)(mk >> 5) * 8 + h) * 2048 + lane * 8;
    KVF<96> A, B, C;
#define CTX_LD(F, t) do { const int tt_ = (t) < 8 ? (t) : 7; const bf16* k_ = Kb + (size_t)tt_ * 16384; const bf16* r_ = Rb + (size_t)tt_ * 1024; const bf16* v_ = Vb + (size_t)tt_ * 16384; \
        F.kf[0] = ld8(k_); F.kf[1] = ld8(k_ + 512); F.kf[2] = ld8(k_ + 1024); F.kf[3] = ld8(k_ + 1536); F.kf[4] = ld8(r_); F.kf[5] = ld8(r_ + 512); \
        F.vf[0][0] = ld8(v_); F.vf[0][1] = ld8(v_ + 512); F.vf[1][0] = ld8(v_ + 1024); F.vf[1][1] = ld8(v_ + 1536); } while (0)
    CTX_LD(A, 0); CTX_LD(B, 1); CTX_LD(C, 2);
#pragma unroll
    for (int t = 0; t < 9; t += 3) {
        attn_compute<96>(A, q, o, m, l, NoMod()); CTX_LD(A, t + 3);
        attn_compute<96>(B, q, o, m, l, NoMod()); CTX_LD(B, t + 4);
        if (t + 2 < 8) { attn_compute<96>(C, q, o, m, l, NoMod()); CTX_LD(C, t + 5); }
    }
#undef CTX_LD
    attn_store(o, l, P3_MIX + mq * 1024 + 256 + h * 64, hi);
}
__device__ __forceinline__ void unit_na_ctx(const P3Ptrs& P, int u, int lane) {
    const int r32 = lane & 31, hi = lane >> 5, kap = (r32 & ~12) | ((r32 & 8) >> 1) | ((r32 & 4) << 1);
    const int qb = u & 7, h = (u >> 3) & 3, b = u >> 5;
    const size_t mq = (size_t)b * 256 + 32 * qb + r32, mk = (size_t)b * 256;
    bf16x8 q[4];
#pragma unroll
    for (int d0 = 0; d0 < 4; ++d0) q[d0] = ld8(P3_QNA + mq * 256 + h * 64 + 16 * d0 + 8 * hi);
    f32x16 o[2];
#pragma unroll
    for (int i = 0; i < 16; ++i) { o[0][i] = 0.f; o[1][i] = 0.f; }
    float m = NEG_BIG, l = 0.f;
    const bf16* Kb = P3_KNA + ((size_t)(mk >> 5) * 4 + h) * 2048;
    const bf16* Vb = P3_VTNA + ((size_t)(mk >> 5) * 4 + h) * 2048;
    KVF<64> A, B, C;
#define CTX_LD(F, t) do { const int tt_ = (t) < 8 ? (t) : 7; kv_load_frag(F, Kb + (size_t)tt_ * 8192, Vb + (size_t)tt_ * 8192, lane); } while (0)
    CTX_LD(A, 0); CTX_LD(B, 1); CTX_LD(C, 2);
#pragma unroll
    for (int t = 0; t < 9; t += 3) {
        attn_compute<64>(A, q, o, m, l, NoMod()); CTX_LD(A, t + 3);
        attn_compute<64>(B, q, o, m, l, NoMod()); CTX_LD(B, t + 4);
        if (t + 2 < 8) { attn_compute<64>(C, q, o, m, l, NoMod()); CTX_LD(C, t + 5); }
    }
#undef CTX_LD
    attn_store(o, l, P3_MIX + mq * 1024 + h * 64, hi);
}
__device__ __forceinline__ void unit_na_lat(const P3Ptrs& P, int u, int lane) {
    const int r32 = lane & 31, hi = lane >> 5, kap = (r32 & ~12) | ((r32 & 8) >> 1) | ((r32 & 4) << 1);
    const int qh = u & 1, gr = (u >> 1) & 31, h = (u >> 6) & 3, b = u >> 8;
    const int c = 32 * qh + r32;
    const size_t mb = (size_t)NCTX + (size_t)b * 2048, mq = mb + gr * 64 + c;
    bf16x8 q[4];
#pragma unroll
    for (int d0 = 0; d0 < 4; ++d0) q[d0] = ld8(P3_QNA + mq * 256 + h * 64 + 16 * d0 + 8 * hi);
    f32x16 o[2];
#pragma unroll
    for (int i = 0; i < 16; ++i) { o[0][i] = 0.f; o[1][i] = 0.f; }
    float m = NEG_BIG, l = 0.f;
    int R0 = gr - 4; R0 = R0 < 0 ? 0 : (R0 > 24 ? 24 : R0);
    const bf16* Kc = P3_KCNA + ((size_t)(b * 8) * 4 + h) * 2048;
    const bf16* Vc = P3_VTCNA + ((size_t)(b * 8) * 4 + h) * 2048;
    const size_t tl0 = ((mb + (size_t)R0 * 64) >> 5);
    const bf16* Kl = P3_KNA + (tl0 * 4 + h) * 2048;
    const bf16* Vl = P3_VTNA + (tl0 * 4 + h) * 2048;
    const float* BT = (const float*)(P.ws + WS_NABT) + (size_t)((P.l * 4 + h) * 16) * 4096 + qh * 2048 + lane * 4;
    const int ro0 = R0 - gr + 7;
#define NA_LOAD(F, Bv, t) do { const int tt_ = (t) < 24 ? (t) : 23; const bool cx_ = tt_ < 8; \
        kv_load_frag(F, cx_ ? Kc + (size_t)tt_ * 8192 : Kl + (size_t)(tt_ - 8) * 8192, cx_ ? Vc + (size_t)tt_ * 8192 : Vl + (size_t)(tt_ - 8) * 8192, lane); \
        const float* bp_ = BT + (size_t)(cx_ ? 15 : ro0 + ((tt_ - 8) >> 1)) * 4096 + (cx_ ? 0 : 1024 * (tt_ & 1)); \
        Bv.b[0] = *(const f32x4*)bp_; Bv.b[1] = *(const f32x4*)(bp_ + 256); Bv.b[2] = *(const f32x4*)(bp_ + 512); Bv.b[3] = *(const f32x4*)(bp_ + 768); } while (0)
    KVF<64> A, B, C; CBias bA, bB, bC;
    NA_LOAD(A, bA, 0); NA_LOAD(B, bB, 1); NA_LOAD(C, bC, 2);
#pragma unroll 1
    for (int t = 0; t < 24; t += 3) {
        attn_compute<64>(A, q, o, m, l, NoMod(), bA); NA_LOAD(A, bA, t + 3);
        attn_compute<64>(B, q, o, m, l, NoMod(), bB); NA_LOAD(B, bB, t + 4);
        attn_compute<64>(C, q, o, m, l, NoMod(), bC); NA_LOAD(C, bC, t + 5);
    }
#undef NA_LOAD
    attn_store(o, l, P3_MIX + mq * 1024 + h * 64, hi);
}
__device__ __forceinline__ void unit_sgu(const P3Ptrs& P, int u, int lane) {
    const int r32 = lane & 31, hi = lane >> 5;
    const int pb = u & 3, g = (u >> 2) & 3, chunk = u >> 4;
    const size_t m0 = (size_t)chunk * 128;
    f32x16 a0, a1;
#pragma unroll
    for (int i = 0; i < 16; ++i) { a0[i] = 0.f; a1[i] = 0.f; }
    const bf16* Wp = P3_WSGU + ((size_t)g * 128 + 32 * pb + r32) * 128 + 8 * hi;
    const bf16* V0 = P3_VTSGU + (size_t)(g * 64 + r32) * MT + m0 + 8 * hi;
    const float* Rp = P3_RSV + m0 + 8 * hi;
#pragma unroll 2
    for (int s = 0; s < 8; ++s) {
        const v4u wr = *(const v4u*)(Wp + 16 * s);
        const f32x4 r0 = *(const f32x4*)(Rp + 16 * s), r1 = *(const f32x4*)(Rp + 16 * s + 4);
        v4u wb; wb.x = cvtpk(bflo(wr.x) * r0.x, bfhi(wr.x) * r0.y); wb.y = cvtpk(bflo(wr.y) * r0.z, bfhi(wr.y) * r0.w);
        wb.z = cvtpk(bflo(wr.z) * r1.x, bfhi(wr.z) * r1.y); wb.w = cvtpk(bflo(wr.w) * r1.z, bfhi(wr.w) * r1.w);
        const bf16x8 bfr = __builtin_bit_cast(bf16x8, wb);
        a0 = mfma32(ld8(V0 + 16 * s), bfr, a0);
        a1 = mfma32(ld8(V0 + (size_t)32 * MT + 16 * s), bfr, a1);
    }
    const float bs = P.b_sgu[g * 128 + 32 * pb + r32];
    const size_t row = m0 + 32 * pb + r32;
#pragma unroll
    for (int blk = 0; blk < 2; ++blk)
#pragma unroll
        for (int gg = 0; gg < 4; ++gg) { const int d0 = g * 64 + 32 * blk + 8 * gg + 4 * hi;
            const u32x2 uu = *(const u32x2*)(P3_U + row * 256 + d0);
            const f32x16& a = blk ? a1 : a0;
            const f32x4 v = {bflo(uu.x) * (a[4 * gg] + bs), bfhi(uu.x) * (a[4 * gg + 1] + bs), bflo(uu.y) * (a[4 * gg + 2] + bs), bfhi(uu.y) * (a[4 * gg + 3] + bs)};
            *(u32x2*)(P3_MIX + row * 1024 + 768 + d0) = pack4(v); }
}


struct DstLin { size_t dpitch; __device__ __forceinline__ size_t operator()(int n, int k) const { return (size_t)n * dpitch + k; } };
struct DstVFrag { __device__ __forceinline__ size_t operator()(int n, int k) const { return vfrag_off((unsigned)k, (unsigned)n >> 6, (unsigned)n & 63u); } };
template <class Map, class Dst>
__device__ __forceinline__ void transpose_item(const float* W, int N, bf16* WT, const Dst& dst, int koff, LAS float* scr, int k0, int n0d, int lane, const Map& map) {
    const int sc = map(n0d + (lane & 31));
    const float msk = sc >= 0 ? 1.f : 0.f; const float* wp = W + (size_t)(k0 + (lane >> 5)) * N + (sc >= 0 ? sc : 0);
    float v[32];
#pragma unroll
    for (int i = 0; i < 32; ++i) v[i] = wp[(size_t)(2 * i) * N];
#pragma unroll
    for (int i = 0; i < 32; ++i) scr[(2 * i + (lane >> 5)) * 33 + (lane & 31)] = v[i] * msk;
    LDS_WAIT(); asm volatile("" ::: "memory");
    const int c = lane & 7;
#pragma unroll
    for (int j = 0; j < 4; ++j) { const int n = (lane >> 3) + 8 * j; const LAS float* s = scr + (8 * c) * 33 + n;
        v4u o; o.x = cvtpk(s[0 * 33], s[1 * 33]); o.y = cvtpk(s[2 * 33], s[3 * 33]); o.z = cvtpk(s[4 * 33], s[5 * 33]); o.w = cvtpk(s[6 * 33], s[7 * 33]);
        *(v4u*)(WT + dst(n0d + n, koff + k0 + 8 * c)) = o; }
    LDS_WAIT(); asm volatile("" ::: "memory");
}
template <class Map>
__device__ __forceinline__ void transpose_item4(const float* W, int N, bf16* WT, size_t dpitch, LAS unsigned char* scr, int k0, int n0d, int lane, const Map& map) {
    const int c4 = lane & 31, kh = lane >> 5;
    const int sc = map(n0d + 4 * c4);
    const float msk = sc >= 0 ? 1.f : 0.f; const float* wp = W + (size_t)(k0 + 32 * kh) * N + (sc >= 0 ? sc : 0);
    f32x4 v[32];
#pragma unroll
    for (int i = 0; i < 32; ++i) v[i] = *(const f32x4*)(wp + (size_t)i * N);
#pragma unroll
    for (int j = 0; j < 4; ++j)
#pragma unroll
        for (int q = 0; q < 4; ++q) { v4u o;
            o.x = cvtpk(v[8 * q + 0][j] * msk, v[8 * q + 1][j] * msk); o.y = cvtpk(v[8 * q + 2][j] * msk, v[8 * q + 3][j] * msk); o.z = cvtpk(v[8 * q + 4][j] * msk, v[8 * q + 5][j] * msk); o.w = cvtpk(v[8 * q + 6][j] * msk, v[8 * q + 7][j] * msk);
            *(LAS v4u*)(scr + (4 * c4 + j) * 128 + (((4 * kh + q) ^ (c4 & 7)) << 4)) = o; }
    LDS_WAIT(); asm volatile("" ::: "memory");
#pragma unroll
    for (int s = 0; s < 16; ++s) { const int p = lane + 64 * s, n = p >> 3, kq = p & 7;
        *(v4u*)(WT + (size_t)(n0d + n) * dpitch + k0 + 8 * kq) = *(const LAS v4u*)(scr + n * 128 + ((kq ^ ((n >> 2) & 7)) << 4)); }
    LDS_WAIT(); asm volatile("" ::: "memory");
}
struct MapId { __device__ __forceinline__ int operator()(int n) const { return n; } };
__device__ __forceinline__ int rope_src(int p) { const int fq = p >> 3, e = p & 7; return (fq >> 1) * 16 + ((e >> 2) << 3) + 4 * (fq & 1) + (e & 3); }
struct MapIn { __device__ __forceinline__ int operator()(int n) const {
    if (n < 768) return n;
    if (n < 1024) return 1152 + (n - 768);
    if (n < 1280) return 1696 + (n - 1024);
    if (n < 1536) return 1440 + (n - 1280);
    if (n < 1920) return 768 + (n - 1536);
    if (n < 1952) return 1408 + rope_src(n - 1920);
    return -1; } };
struct MapUq { __device__ __forceinline__ int operator()(int n) const {
    if (n < 512) return (n >> 6) * 96 + (n & 63);
    const int h = (n - 512) >> 5, p = (n - 512) & 31; return h * 96 + 64 + rope_src(p); } };
struct MapF1 { __device__ __forceinline__ int operator()(int n) const { return (n >> 8) * 128 + (n & 127) + ((n & 128) ? DFF : 0); } };
struct MapUkv { __device__ __forceinline__ int operator()(int n) const {
    if (n < 512) return (n >> 6) * 128 + (n & 63);
    return ((n - 512) >> 6) * 128 + 64 + (n & 63); } };


template <bool CONTIG, class Map>
__device__ __forceinline__ void gemv5_item(const float* W, int N, const Map& map, int n0, const LAS float* S, LAS float* part, const float* badd, float* dst, size_t dstride, int wave, int lane, int tid) {
    const int c0 = map(n0 + 2 * lane), c1 = map(n0 + 2 * lane + 1);
    const float m0 = c0 >= 0 ? 1.f : 0.f, m1 = c1 >= 0 ? 1.f : 0.f; const int i0 = c0 >= 0 ? c0 : 0, i1 = c1 >= 0 ? c1 : 0;
    float a[5][2];
#pragma unroll
    for (int r = 0; r < 5; ++r) { a[r][0] = 0.f; a[r][1] = 0.f; }
    const float* wp = W + (size_t)(wave * 128) * N;
    float wa0[16], wa1[16], wb0[16], wb1[16];
#define GEMV_LOAD(w0_, w1_, kb_) do { _Pragma("unroll") for (int k = 0; k < 16; ++k) { \
        if (CONTIG) { const f32x2 t_ = *(const f32x2*)(wp + (size_t)((kb_) + k) * N + i0); w0_[k] = t_.x; w1_[k] = t_.y; } \
        else { w0_[k] = wp[(size_t)((kb_) + k) * N + i0] * m0; w1_[k] = wp[(size_t)((kb_) + k) * N + i1] * m1; } } } while (0)
#define GEMV_FMA(w0_, w1_, kb_) do { _Pragma("unroll") for (int k = 0; k < 16; ++k) _Pragma("unroll") for (int r = 0; r < 5; ++r) { \
        const float s_ = S[r * 1024 + wave * 128 + (kb_) + k]; a[r][0] += s_ * w0_[k]; a[r][1] += s_ * w1_[k]; } } while (0)
    GEMV_LOAD(wa0, wa1, 0);
#pragma unroll 1
    for (int kb = 0; kb < 128; kb += 32) {
        GEMV_LOAD(wb0, wb1, kb + 16);
        asm volatile("" ::: "memory"); __builtin_amdgcn_sched_barrier(0);
        GEMV_FMA(wa0, wa1, kb);
        asm volatile("" ::: "memory"); __builtin_amdgcn_sched_barrier(0);
        { const int kn = kb + 32 < 128 ? kb + 32 : 0; GEMV_LOAD(wa0, wa1, kn); }
        asm volatile("" ::: "memory"); __builtin_amdgcn_sched_barrier(0);
        GEMV_FMA(wb0, wb1, kb + 16);
    }
#undef GEMV_LOAD
#undef GEMV_FMA
#pragma unroll
    for (int r = 0; r < 5; ++r) { part[(wave * 5 + r) * 128 + 2 * lane] = a[r][0]; part[(wave * 5 + r) * 128 + 2 * lane + 1] = a[r][1]; }
    __syncthreads();
    for (int i = tid; i < 640; i += NTHR) { const int r = i >> 7, cc = i & 127; float s = badd ? badd[n0 + cc] : 0.f;
#pragma unroll
        for (int w = 0; w < 8; ++w) s += part[(w * 5 + r) * 128 + cc];
        dst[(size_t)r * dstride + n0 + cc] = s; }
    __syncthreads();
}
__device__ __forceinline__ void mods_work(const float* c_lat, const float* c_ctx, const float* w_mod, const float* b_mod, float* MODS, LAS unsigned char* lds, int l_lo, int l_hi, int widx, int wcnt, int wave, int lane, int tid) {
    LAS float* sc = (LAS float*)lds;
    LAS float* part = (LAS float*)(lds + 20480);
    for (int i = tid; i < 5 * 1024; i += NTHR) { const int r = i >> 10, k = i & 1023; const float cv = (r == 0) ? c_ctx[k] : c_lat[(r - 1) * 1024 + k]; sc[i] = cv / (1.0f + expf(-cv)); }
    __syncthreads();
    for (int item = widx; item < (l_hi - l_lo) * 48; item += wcnt) {
        const int l = l_lo + item / 48, n0 = (item % 48) * 128;
        gemv5_item<true>(w_mod + (size_t)l * 1024 * NMOD, NMOD, MapId(), n0, sc, part, b_mod + (size_t)l * NMOD, MODS + (size_t)l * 5 * NMOD, (size_t)NMOD, wave, lane, tid);
    }
    __syncthreads();
}
__device__ __forceinline__ void bias_work_f32(const float* w_in_l, const float* w_ffn_in_l, const float* MODS_l, float* B1_l, float* B2_l, LAS unsigned char* lds, int widx, int wcnt, int wave, int lane, int tid, int item_lo, int item_hi) {
    LAS float* s1 = (LAS float*)lds;
    LAS float* s2 = (LAS float*)(lds + 20480);
    LAS float* part = (LAS float*)(lds + 40960);
    for (int i = tid; i < 5 * 1024; i += NTHR) { const int r = i >> 10, k = i & 1023; s1[i] = MODS_l[(size_t)r * NMOD + k]; s2[i] = MODS_l[(size_t)r * NMOD + 3072 + k]; }
    __syncthreads();
    for (int item = item_lo + widx; item < item_hi; item += wcnt) {
        if (item < 16) gemv5_item<false>(w_in_l, NIN, MapIn(), item * 128, s1, part, nullptr, B1_l, (size_t)NINP, wave, lane, tid);
        else gemv5_item<true>(w_ffn_in_l, NFF, MapF1(), (item - 16) * 128, s2, part, nullptr, B2_l, (size_t)NFF, wave, lane, tid);
    }
    __syncthreads();
}

typedef __attribute__((address_space(4))) const unsigned char* kptr_t;
__device__ __forceinline__ kptr_t kargs() { kptr_t p = (kptr_t)__builtin_amdgcn_kernarg_segment_ptr(); asm volatile("" : "+s"(p)); return p; }
#define KIN(i) (*(const float* const __attribute__((address_space(4)))*)(kp + 8 * (i)))
#define KOUT() (*(float* const __attribute__((address_space(4)))*)(kp + 216))
#define KWS() (*(unsigned char* const __attribute__((address_space(4)))*)(kp + 224))
#define WSP(T, off) ((T*)(ws + (off)))

constexpr int W_IN = 1, W_UQ = 2, W_UKV = 4, W_OUT = 8, W_F1 = 16, W_F2 = 32;
__device__ __forceinline__ void weight_transposes(kptr_t kp, unsigned char* ws, LAS unsigned char* lds, int l, int widx, int wcnt, int wave, int lane, const int mask) {
    LAS unsigned char* scr = lds + wave * 16384;
    constexpr int I_IN = 16 * 16, I_UQ = 6 * 6, I_UKV = 4 * 8, I_OUT = 16 * 8, I_F1 = 16 * 44, I_F2 = 44 * 8;
    const int total = ((mask & W_IN) ? I_IN : 0) + ((mask & W_UQ) ? I_UQ : 0) + ((mask & W_UKV) ? I_UKV : 0) + ((mask & W_OUT) ? I_OUT : 0) + ((mask & W_F1) ? I_F1 : 0) + ((mask & W_F2) ? I_F2 : 0);
    for (int it = widx; it < total; it += wcnt) {
        int r = it;
        if (mask & W_IN) { if (r < I_IN) { transpose_item4(KIN(11) + (size_t)l * 1024 * NIN, NIN, WSP(bf16, WS_WIN) + (size_t)l * NINP * 1024, (size_t)1024, scr, (r / 16) * 64, (r % 16) * 128, lane, MapIn()); continue; } r -= I_IN; }
        if (mask & W_UQ) { if (r < I_UQ) { transpose_item4(KIN(14) + (size_t)l * 384 * 768, 768, WSP(bf16, WS_WUQ) + (size_t)l * 768 * 384, (size_t)384, scr, (r / 6) * 64, (r % 6) * 128, lane, MapUq()); continue; } r -= I_UQ; }
        if (mask & W_UKV) { if (r < I_UKV) { transpose_item4(KIN(16) + (size_t)l * 256 * 1024, 1024, WSP(bf16, WS_WUKV) + (size_t)l * 1024 * 256, (size_t)256, scr, (r / 8) * 64, (r % 8) * 128, lane, MapUkv()); continue; } r -= I_UKV; }
        if (mask & W_OUT) { if (r < I_OUT) { transpose_item4(KIN(20) + (size_t)l * 1024 * 1024, 1024, WSP(bf16, WS_WOUT) + (size_t)l * 1024 * 1024, (size_t)1024, scr, (r / 8) * 64, (r % 8) * 128, lane, MapId()); continue; } r -= I_OUT; }
        if (mask & W_F1) { if (r < I_F1) { transpose_item4(KIN(22) + (size_t)l * 1024 * NFF, NFF, WSP(bf16, WS_WF1), (size_t)1024, scr, (r / 44) * 64, (r % 44) * 128, lane, MapF1()); continue; } r -= I_F1; }
        if (mask & W_F2) transpose_item4(KIN(25) + (size_t)l * DFF * 1024, 1024, WSP(bf16, WS_WF2) + (size_t)l * 1024 * DFF, (size_t)DFF, scr, (r / 8) * 64, (r % 8) * 128, lane, MapId());
    }
}

#ifndef P6_KH
#define P6_KH 6
#endif
#ifndef EN_MASK
#define EN_MASK 0xFFFFF
#endif
#define EN(n) (((EN_MASK) >> (n)) & 1)
#ifndef REP_MASK
#define REP_MASK 0
#endif
#define NREP(n) (1 + (((REP_MASK) >> (n)) & 1))
__global__ void __launch_bounds__(NTHR, 2) fwd_megakernel(Args args) {
    extern __shared__ __attribute__((aligned(16))) unsigned char lds_raw[];
    LAS unsigned char* lds = (LAS unsigned char*)lds_raw;
    const int wave0 = __builtin_amdgcn_readfirstlane((int)threadIdx.x >> 6);
    const int G0 = gridDim.x, bx0 = blockIdx.x;
#define PHASE_VARS() \
    kptr_t kp = kargs(); unsigned char* ws = KWS(); (void)ws; \
    int G = G0, bx = bx0, wave = wave0; asm volatile("" : "+s"(G), "+s"(bx), "+s"(wave)); \
    const int vcu = (G % 8 == 0) ? (bx % 8) * (G / 8) + bx / 8 : bx; \
    const int gw = vcu * NWAVES + wave, NGW = G * NWAVES, NGT = G * NTHR; \
    const int lane = pg8::pg8_lane_id_v(); const int tid = wave * 64 + lane; const int gt = vcu * NTHR + tid; \
    (void)gw; (void)NGW; (void)NGT; (void)gt; (void)tid;

    { PHASE_VARS();
      for (int i = tid; i < 64; i += NTHR) ((LAS unsigned*)(lds + LDS_MISC))[i] = 0u;
      __syncthreads();
      (void)xcd_barrier_post((unsigned*)(ws + WS_CTL) + CW_BAR, (volatile LAS unsigned*)(lds + LDS_MISC + 32), tid == 0); }
#define GRID_BAR_STR2(x) #x
#define GRID_BAR_STR(x) GRID_BAR_STR2(x)
#define GRID_BAR() do { asm volatile("; GRIDBAR line " GRID_BAR_STR(__LINE__)); kptr_t kpb = kargs(); XcdBarrier bb; bb.bar = (unsigned*)((*(unsigned char* const __attribute__((address_space(4)))*)(kpb + 224)) + WS_CTL) + CW_BAR; bb.x = xb_xcc_id(); bb.st = (volatile LAS unsigned*)(lds + LDS_MISC + 32); for (int rb_ = 0; rb_ < NREP(17); ++rb_) xcd_barrier(bb, wave0 == 0 && pg8::pg8_lane_id_v() == 0); } while (0)

    for (int rep_ = 0; rep_ < NREP(0); ++rep_) if (EN(0)) {
        PHASE_VARS();
        mods_work(KIN(6), KIN(7), KIN(8), KIN(9), WSP(float, WS_MODS), lds, 0, 2, bx, G, wave, lane, tid);
    }
    for (int rep_ = 0; rep_ < NREP(1); ++rep_) if (EN(1)) {
        PHASE_VARS();
        const bool act_ = (G != 256) || bx >= 96;
        const int gw_ = (G == 256) ? (bx - 96) * NWAVES + wave : gw, NGW_ = (G == 256) ? 160 * NWAVES : NGW, gt_ = (G == 256) ? (bx - 96) * NTHR + tid : gt, NGT_ = (G == 256) ? 160 * NTHR : NGT; (void)gw_; (void)NGW_; (void)gt_; (void)NGT_;
        if (act_) {
        weight_transposes(kp, ws, lds, 0, gw_, NGW_, wave, lane, W_IN);
        LAS float* scr = (LAS float*)(lds + wave * 16384);
        for (int it = gw_; it < DEPTH * 128; it += NGW_) { const int l = it >> 7, r = it & 127, b = r >> 5, q = r & 31;
            transpose_item(KIN(3) + (size_t)(b * 4 + l) * 256 * 256, 256, WSP(bf16, WS_VTCNA) + (size_t)l * 256 * 1024, DstVFrag(), b * 256, scr, (q / 8) * 64, (q % 8) * 32, lane, MapId()); }
        }
    }
    for (int rep_ = 0; rep_ < NREP(2); ++rep_) if (EN(2)) {
        PHASE_VARS();
        const bool act_ = (G != 256) || bx >= 96;
        const int gw_ = (G == 256) ? (bx - 96) * NWAVES + wave : gw, NGW_ = (G == 256) ? 160 * NWAVES : NGW, gt_ = (G == 256) ? (bx - 96) * NTHR + tid : gt, NGT_ = (G == 256) ? 160 * NTHR : NGT; (void)gw_; (void)NGW_; (void)gt_; (void)NGT_;
        if (act_) {
        const float* cache_na_k = KIN(2); const float* cache_ckv = KIN(4); const float* cache_kr = KIN(5); const float* w_sgu = KIN(18);
        bf16* KCNA = WSP(bf16, WS_KCNA); bf16* CKVC = WSP(bf16, WS_CKVC); bf16* KRC = WSP(bf16, WS_KRC); bf16* WSGU = WSP(bf16, WS_WSGU); float* ROPE = WSP(float, WS_ROPE);
        for (int i = gt_; i < 262144; i += NGT_) {
            const int e = i * 4, c4 = e & 255, key = (e >> 8) & 255, l = (e >> 16) & 3, b = e >> 18;
            const size_t dd = ((size_t)(l * 4 + b) * 256 + key) * 256 + c4;
            *(u32x2*)(KCNA + (size_t)l * 262144 + kfrag_off((unsigned)(b * 256 + key), (unsigned)c4 >> 6, ((unsigned)c4 & 63u) >> 3) + (c4 & 4)) = pack4(*(const f32x4*)(cache_na_k + e)); *(u32x2*)(CKVC + dd) = pack4(*(const f32x4*)(cache_ckv + e));
        }
        for (int i = gt_; i < 32768; i += NGT_) {
            const int e = i * 4, c4 = e & 31, key = (e >> 5) & 255, l = (e >> 13) & 3, b = e >> 15;
            *(u32x2*)(KRC + ((size_t)(l * 4 + b) * 256 + key) * 32 + c4) = pack4(*(const f32x4*)(cache_kr + e));
        }
        for (int i = gt_; i < 65536; i += NGT_) *(u32x2*)(WSGU + (size_t)i * 4) = pack4(*(const f32x4*)(w_sgu + (size_t)i * 4));
        {
            const float* na_rpb = KIN(12); float* BT = WSP(float, WS_NABT);
            for (int i = gt_; i < 4 * 4 * 16 * 4096; i += NGT_) { const int e = i & 3, ln = (i >> 2) & 63, piece = (i >> 8) & 3, half = (i >> 10) & 1, qh = (i >> 11) & 1, ro = (i >> 12) & 15, lh = i >> 16;
                const int c = 32 * qh + (ln & 31), kc = 32 * half + 16 * (piece >> 1) + 8 * (ln >> 5) + 4 * (piece & 1) + e;
                int cs = c - 8; cs = cs < 0 ? 0 : (cs > 48 ? 48 : cs); int co = kc - c; co = co < -15 ? -15 : (co > 15 ? 15 : co);
                const bool ok = (unsigned)(kc - cs) < 16u;
                BT[i] = (ro == 15) ? 0.f : (ok ? na_rpb[(size_t)(lh * 15 + ro) * 31 + co + 15] * LOG2E : NEG_BIG); }
        }
        for (int i = gt_; i < 512; i += NGT_) { const int pos = i >> 3, f = i & 7; const float inv = powf(10000.0f, -(float)f / 8.0f); const float ang = (float)pos * inv; ROPE[2 * i] = cosf(ang); ROPE[2 * i + 1] = sinf(ang); }
        }
    }
    GRID_BAR();
    for (int rep_ = 0; rep_ < NREP(3); ++rep_) if (EN(3)) {
        PHASE_VARS();
        const bf16* WIN = WSP(bf16, WS_WIN); const bf16* WF1 = WSP(bf16, WS_WF1); const float* MODS = WSP(float, WS_MODS); float* B1 = WSP(float, WS_B1); float* B2 = WSP(float, WS_B2);
        for (int it = gw; it < NINP; it += NGW) {
            const int l = it / (NINP + NFF), cc = it % (NINP + NFF);
            const bf16* wrow; const float* sh; float* dst; int dstride;
            if (cc < NINP) { wrow = WIN + ((size_t)l * NINP + cc) * 1024; sh = MODS + (size_t)l * 5 * NMOD; dst = B1 + (size_t)l * 5 * NINP + cc; dstride = NINP; }
            else { wrow = WF1 + ((size_t)l * NFF + (cc - NINP)) * 1024; sh = MODS + (size_t)l * 5 * NMOD + 3072; dst = B2 + (size_t)l * 5 * NFF + (cc - NINP); dstride = NFF; }
            const v4u w0 = *(const v4u*)(wrow + 16 * lane), w1 = *(const v4u*)(wrow + 16 * lane + 8);
            const float wf[16] = {bflo(w0.x), bfhi(w0.x), bflo(w0.y), bfhi(w0.y), bflo(w0.z), bfhi(w0.z), bflo(w0.w), bfhi(w0.w),
                                  bflo(w1.x), bfhi(w1.x), bflo(w1.y), bfhi(w1.y), bflo(w1.z), bfhi(w1.z), bflo(w1.w), bfhi(w1.w)};
#pragma unroll
            for (int r = 0; r < 5; ++r) { const f32x4* sp = (const f32x4*)(sh + (size_t)r * NMOD + 16 * lane); float s = 0.f;
#pragma unroll
                for (int q = 0; q < 4; ++q) { const f32x4 v = sp[q]; s += (v.x * wf[4 * q] + v.y * wf[4 * q + 1]) + (v.z * wf[4 * q + 2] + v.w * wf[4 * q + 3]); }
                s = wave_sum(s); if (lane == 0) dst[(size_t)r * dstride] = s; }
        }
    }
    for (int rep_ = 0; rep_ < NREP(4); ++rep_) if (EN(4)) {
        PHASE_VARS();
        const float* x_prompt = KIN(0); const float* x_sample = KIN(1); const float* g_mix = KIN(10); const float* MODS = WSP(float, WS_MODS); bf16* XA = WSP(bf16, WS_XA); bf16* XR = WSP(bf16, WS_XR); float* SSQX = WSP(float, WS_SSQX);
        for (int m0 = gw; m0 < MT; m0 += 3 * NGW) {
            f32x4 v[3][4];
#pragma unroll
            for (int u = 0; u < 3; ++u) { const int mu = m0 + u * NGW, m = mu < MT ? mu : m0;
                const float* xr = (m < NCTX) ? x_prompt + (size_t)m * DM : x_sample + (size_t)(m - NCTX) * DM;
#pragma unroll
                for (int j = 0; j < 4; ++j) v[u][j] = *(const f32x4*)(xr + 4 * lane + 256 * j); }
#pragma unroll
            for (int u = 0; u < 3; ++u) { const int m = m0 + u * NGW;
                if (m < MT) {
                    const int r = (m < NCTX) ? 0 : 1 + ((m - NCTX) >> 11);
                    const float* sc1 = MODS + (size_t)r * NMOD + 1024;
                    float ss = 0.f;
#pragma unroll
                    for (int j = 0; j < 4; ++j) { const int col = 4 * lane + 256 * j; const f32x4 vv = v[u][j]; ss += sq4(vv);
                        const f32x4 gm = *(const f32x4*)(g_mix + col) * (*(const f32x4*)(sc1 + col) + 1.0f);
                        *(u32x2*)(XA + (size_t)m * DM + col) = pack4(vv * gm); { u32x2 w; w.x = cvtpkh(vv.x, vv.y); w.y = cvtpkh(vv.z, vv.w); *(u32x2*)(XR + (size_t)m * DM + col) = w; } }
                    ss = wave_sum(ss);
                    if (lane < 4) SSQX[(size_t)m * 4 + lane] = (lane == 0) ? ss : 0.f;
                } }
        }
    }
    GRID_BAR();

    for (int l = 0; l < DEPTH; ++l) {
        for (int rep_ = 0; rep_ < NREP(5); ++rep_) if (EN(5)) {
            PHASE_VARS();
            pg8::Gemm g{WSP(bf16, WS_XA), WSP(bf16, WS_WIN) + (size_t)l * NINP * 1024, MT, NINP, 1024}; pg8::StaticOrder S; S.init(MT, NINP, G, bx);
            EpiIn E; E.l = l; E.ws = ws; E.out = KOUT(); E.lds = lds; E.rowfn.ssqx = ws + WS_SSQX; E.colfn.bias = WSP(float, WS_B1) + (size_t)l * 5 * NINP; E.colfn.g_ckv = KIN(15) + l * 256; E.colfn.g_sgu = KIN(17) + l * 256; E.colfn.g_cq = KIN(13) + l * 384;
            if (G == 256) { pg8::SchedP1 S1; S1.init(bx); pg8::gemm_phase<EpiIn, pg8::SchedP1, true, true>(lds, g, S1, E, wave); }
            else pg8::gemm_phase<EpiIn, pg8::StaticOrder, true, true>(lds, g, S, E, wave);
        }
        for (int rep_ = 0; rep_ < NREP(5); ++rep_) {
            PHASE_VARS();
            const int nidle = (G == 256) ? 128 : 0;
            if (nidle == 0 || bx >= 128) {
                const int widx = nidle ? bx - 128 : bx, wcnt = nidle ? nidle : G;
                const int ngemv = wcnt >= 88 ? 44 : 0;
                if (ngemv == 0 || widx < ngemv)
                    bias_work_f32(KIN(11) + (size_t)l * 1024 * NIN, KIN(22) + (size_t)l * 1024 * NFF, WSP(float, WS_MODS) + (size_t)l * 5 * NMOD,
                                  WSP(float, WS_B1) + (size_t)l * 5 * NINP, WSP(float, WS_B2) + (size_t)l * 5 * NFF, lds, widx, ngemv ? ngemv : wcnt, wave, lane, tid, 16, 60);
                if (ngemv == 0 || widx >= ngemv)
                    weight_transposes(kp, ws, lds, l, (ngemv ? widx - ngemv : widx) * NWAVES + wave, (ngemv ? wcnt - ngemv : wcnt) * NWAVES, wave, lane, nidle ? (W_UQ | W_UKV | W_OUT) : (W_UQ | W_UKV | W_OUT | W_F1));
                if (nidle && l + 1 < DEPTH && (ngemv == 0 || widx >= ngemv)) weight_transposes(kp, ws, lds, l + 1, (widx - ngemv) * NWAVES + wave, (wcnt - ngemv) * NWAVES, wave, lane, W_IN);
            }
        }
        GRID_BAR();
        for (int rep_ = 0; rep_ < NREP(6); ++rep_) if (EN(6)) {
            PHASE_VARS();
            pg8::Gemm g{WSP(bf16, WS_CQ), WSP(bf16, WS_WUQ) + (size_t)l * 768 * 384, MT, 768, 384}; pg8::StaticOrder S; S.init(MT, 768, G, G == 256 ? ((bx + 144) & 255) : bx);
            EpiQ E; E.ws = ws; E.lds = lds; E.rowfn.ssq1 = ws + WS_SSQ1;
            pg8::gemm_phase<EpiQ, pg8::StaticOrder, true, true>(lds, g, S, E, wave);
        }
        for (int rep_ = 0; rep_ < NREP(7); ++rep_) for (int part = 0; part < 2; ++part) {
            PHASE_VARS();
            pg8::Gemm g; EpiKV E; pg8::StaticOrder S; E.lds = lds;
            g.Bt = WSP(bf16, WS_WUKV) + (size_t)l * 1024 * 256; g.N = 1024; g.K = 256;
            if (part == 0) { g.A = WSP(bf16, WS_CKV); g.M = MT; E.rowfn.ssq1 = ws + WS_SSQ1; E.rowfn.use = true; E.K = WSP(bf16, WS_KMLA); E.VT = WSP(bf16, WS_VTMLA); E.vtpitch = MT; E.KF = WSP(bf16, WS_KMLA); E.VF = WSP(bf16, WS_VFM); }
            else { g.A = WSP(bf16, WS_CKVC) + (size_t)l * 1024 * 256; g.M = 1024; E.rowfn.ssq1 = ws + WS_SSQ1; E.rowfn.use = false; E.K = WSP(bf16, WS_KCMLA) + (size_t)l * 1024 * 512; E.VT = WSP(bf16, WS_VTCMLA) + (size_t)l * 512 * 1024; E.vtpitch = 1024; E.KF = nullptr; E.VF = nullptr; }
            if (G == 256) { if (part == 0) S.init(g.M, 1024, 112, bx < 112 ? bx : 192); else S.init(g.M, 1024, G, (bx + 176) & 255); }
            else S.init(g.M, 1024, G, bx);
            pg8::gemm_phase<EpiKV, pg8::StaticOrder, true, true>(lds, g, S, E, wave);
        }
        {
            PHASE_VARS();
            if (G == 256 && bx >= 96) weight_transposes(kp, ws, lds, l, (bx - 96) * NWAVES + wave, 160 * NWAVES, wave, lane, W_F1);
        }
        for (int rep_ = 0; rep_ < NREP(8); ++rep_) if (EN(8)) {
            PHASE_VARS(); float* out = KOUT();
            float* RSV = WSP(float, WS_RSV); const float* SSQ1 = WSP(float, WS_SSQ1);
            for (int m = gt; m < MT; m += NGT) RSV[m] = rsqrtf(sum4(*(const f32x4*)(SSQ1 + (size_t)m * 16 + 4)) * (1.0f / 256.0f) + EPS);
            for (int i = gt; i < NCTX * 64; i += NGT) { const int row = i >> 6, c4 = (i & 63) * 4, b = row >> 8, t = row & 255;
                const float rs = rsqrtf(sum4(*(const f32x4*)(SSQ1 + (size_t)row * 16)) * (1.0f / 256.0f) + EPS);
                f32x4* p = (f32x4*)(out + OUT_CKV + ((size_t)(b * 4 + l) * 256 + t) * 256 + c4); *p = *p * rs; }
        }
        GRID_BAR();
        for (int rep_ = 0; rep_ < NREP(9); ++rep_) if (EN(9)) {
            PHASE_VARS();
            P3Ptrs P; P.ws = ws; P.l = l; P.b_sgu = KIN(19) + l * 512;
            for (int rep2_ = 0; rep2_ < NREP(15); ++rep2_) for (int u = vcu; u < 256; u += G) unit_mla_lat_wg(P, u, wave, pg8::pg8_lane_id_v(), lds);
            for (int rep2_ = 0; rep2_ < NREP(16); ++rep2_) for (int i = gw; i < 2048; i += NGW) {
                const int j = i >> 1;
                if ((i & 1) == 0) unit_na_lat(P, j, pg8::pg8_lane_id_v());
                else { unit_mla_ctx(P, j, pg8::pg8_lane_id_v()); if (j < 512) unit_na_ctx(P, j, pg8::pg8_lane_id_v()); unit_sgu(P, j, pg8::pg8_lane_id_v()); if (j >= 512) unit_sgu(P, j + 512, pg8::pg8_lane_id_v()); }
            }
        }
        GRID_BAR();
        for (int rep_ = 0; rep_ < NREP(10); ++rep_) if (EN(10)) {
            PHASE_VARS(); float* out = KOUT();
            const float* modl = WSP(float, WS_MODS) + (size_t)l * 5 * NMOD;
            pg8::Gemm g{WSP(bf16, WS_MIX), WSP(bf16, WS_WOUT) + (size_t)l * 1024 * 1024, MT, 1024, 1024}; pg8::StaticOrder S; S.init(MT, 1024, G, bx);
            EpiRes<false> E; E.pslot = nullptr; E.pflag = nullptr; E.colfn.gate = modl + 2048; E.colfn.gnext = KIN(21) + l * 1024; E.colfn.scnext = modl + 4096;  E.xr = WSP(bf16, WS_XR); E.XA = WSP(bf16, WS_XA);
            E.ssqx = WSP(float, WS_SSQX); E.lds = lds;
            pg8::gemm_phase<EpiRes<false>, pg8::StaticOrder, true, true>(lds, g, S, E, wave);
        }
        for (int rep_ = 0; rep_ < NREP(10); ++rep_) {
            PHASE_VARS();
            const int nidle = G > 192 ? G - 192 : 0;
            if (nidle == 0 || bx >= 192) {
                const int widx = nidle ? bx - 192 : bx, wcnt = nidle ? nidle : G;
                const int nm = wcnt >= 64 ? 48 : 0;
                if (l + 2 < DEPTH && (nm == 0 || widx < nm)) mods_work(KIN(6), KIN(7), KIN(8), KIN(9), WSP(float, WS_MODS), lds, l + 2, l + 3, widx, nm ? nm : wcnt, wave, lane, tid);
                if (l + 1 < DEPTH && (nm == 0 || widx >= nm))
                    bias_work_f32(KIN(11) + (size_t)(l + 1) * 1024 * NIN, KIN(22) + (size_t)(l + 1) * 1024 * NFF, WSP(float, WS_MODS) + (size_t)(l + 1) * 5 * NMOD,
                                  WSP(float, WS_B1) + (size_t)(l + 1) * 5 * NINP, WSP(float, WS_B2) + (size_t)(l + 1) * 5 * NFF, lds, nm ? widx - nm : widx, nm ? wcnt - nm : wcnt, wave, lane, tid, 0, 16);
                weight_transposes(kp, ws, lds, l, widx * NWAVES + wave, wcnt * NWAVES, wave, lane, W_F2);
                if (l + 1 < DEPTH && G != 256) weight_transposes(kp, ws, lds, l + 1, widx * NWAVES + wave, wcnt * NWAVES, wave, lane, W_IN);
            }
        }
        GRID_BAR();
        for (int rep_ = 0; rep_ < NREP(11); ++rep_) if (EN(11)) {
            PHASE_VARS();
            pg8::Gemm g{WSP(bf16, WS_XA), WSP(bf16, WS_WF1), MT, NFF, 1024}; pg8::StaticOrder S; S.init(MT, NFF, G, bx);
            EpiFF1 E; E.rowfn.ssqx = ws + WS_SSQX; E.colfn.bias = WSP(float, WS_B2) + (size_t)l * 5 * NFF; E.colfn.cw = KIN(23) + (size_t)l * 3 * NFF; E.colfn.cb = KIN(24) + (size_t)l * NFF;
            E.ACT = WSP(bf16, WS_ACT); E.EDGE_A = WSP(float, WS_EDGE_A); E.EDGE_P = WSP(float, WS_EDGE_P); E.lds = lds;
            if (G == 256) {
                pg8::SchedSK5 SK; SK.init(bx, (unsigned*)(ws + WS_CTL) + CW_SKF + l * 256, WSP(float, WS_PART), true);
                pg8::EpiPartOut EP; EP.slot = SK.slot_out(); EP.flag = SK.flag_out(); EP.step = 0;
                pg8::gemm_phase<pg8::EpiPartOut, pg8::SchedSK5, true, true>(lds, g, SK, EP, wave);
                SK.init(bx, (unsigned*)(ws + WS_CTL) + CW_SKF + l * 256, WSP(float, WS_PART), false);
                pg8::gemm_phase<EpiFF1, pg8::SchedSK5, true, true>(lds, g, SK, E, wave);
            }
            else pg8::gemm_phase<EpiFF1, pg8::StaticOrder, true, true>(lds, g, S, E, wave);
        }
        GRID_BAR();
        for (int rep_ = 0; rep_ < NREP(13); ++rep_) if (EN(13)) {
            PHASE_VARS(); float* out = KOUT();
            const float* modl = WSP(float, WS_MODS) + (size_t)l * 5 * NMOD;
            pg8::Gemm g{WSP(bf16, WS_ACT), WSP(bf16, WS_WF2) + (size_t)l * 1024 * DFF, MT, 1024, DFF}; const int ln = (l + 1 < DEPTH) ? l + 1 : l;
            if (G == 256) {
                constexpr int KT = DFF / 64, KH = P6_KH;
                pg8::SchedAssist S; S.init(MT, 1024, G, bx, KT, KH);
                { pg8::Unit u0; for (int i = 0; S.next(i, u0); ++i) conv_fixup(u0.pm, WSP(bf16, WS_ACT), WSP(float, WS_EDGE_A), WSP(float, WS_EDGE_P), KIN(23) + (size_t)l * 3 * NFF, tid); asm volatile("s_waitcnt vmcnt(0)" ::: "memory"); __syncthreads(); }
                unsigned* flg = (unsigned*)(ws + WS_CTL) + CW_SKF + 1024 + l * 192;
                if (bx >= 192) { pg8::EpiPartOut EP; EP.slot = WSP(float, WS_PART) + (size_t)S.c0 * 65536; EP.flag = flg + S.c0; EP.step = 8; pg8::gemm_phase<pg8::EpiPartOut, pg8::SchedAssist, true, true>(lds, g, S, EP, wave); }
                else {
                    EpiRes<true> E; E.pslot = WSP(float, WS_PART) + (size_t)bx * 65536; E.pflag = flg + bx;
                    E.colfn.gate = modl + 5120; E.colfn.gnext = KIN(10) + ln * 1024; E.colfn.scnext = WSP(float, WS_MODS) + (size_t)ln * 5 * NMOD + 1024;  E.xr = WSP(bf16, WS_XR); E.XA = (l + 1 < DEPTH) ? WSP(bf16, WS_XA) : nullptr;
                    E.ssqx = WSP(float, WS_SSQX); E.lds = lds;
                    pg8::gemm_phase<EpiRes<true>, pg8::SchedAssist, true, true>(lds, g, S, E, wave);
                }
            } else {
            pg8::StaticOrder S; S.init(MT, 1024, G, bx);
            { pg8::Unit u0; if (S.next(0, u0)) conv_fixup(u0.pm, WSP(bf16, WS_ACT), WSP(float, WS_EDGE_A), WSP(float, WS_EDGE_P), KIN(23) + (size_t)l * 3 * NFF, tid); asm volatile("s_waitcnt vmcnt(0)" ::: "memory"); __syncthreads(); }
            EpiRes<false> E; E.pslot = nullptr; E.pflag = nullptr; E.colfn.gate = modl + 5120; E.colfn.gnext = KIN(10) + ln * 1024; E.colfn.scnext = WSP(float, WS_MODS) + (size_t)ln * 5 * NMOD + 1024;  E.xr = WSP(bf16, WS_XR); E.XA = (l + 1 < DEPTH) ? WSP(bf16, WS_XA) : nullptr;
            E.ssqx = WSP(float, WS_SSQX); E.lds = lds;
            pg8::gemm_phase<EpiRes<false>, pg8::StaticOrder, true, true>(lds, g, S, E, wave);
            }
        }
        GRID_BAR();
    }
    for (int rep_ = 0; rep_ < NREP(14); ++rep_) if (EN(14)) {
        PHASE_VARS(); float* out = KOUT();
        const float* g_final = KIN(26); const float* SSQX = WSP(float, WS_SSQX); const bf16* XR = WSP(bf16, WS_XR);
        for (int m0 = gw; m0 < MT; m0 += 3 * NGW) {
            u32x2 w[3][4]; f32x4 sq[3];
#pragma unroll
            for (int u = 0; u < 3; ++u) { const int mu = m0 + u * NGW, m = mu < MT ? mu : m0; sq[u] = *(const f32x4*)(SSQX + (size_t)m * 4);
#pragma unroll
                for (int j = 0; j < 4; ++j) w[u][j] = *(const u32x2*)(XR + (size_t)m * DM + 4 * lane + 256 * j); }
#pragma unroll
            for (int u = 0; u < 3; ++u) { const int m = m0 + u * NGW;
                if (m < MT) { float* xr = out + (size_t)m * DM;
                    const float rstd = rsqrtf(sum4(sq[u]) * (1.0f / 1024.0f) + EPS);
#pragma unroll
                    for (int j = 0; j < 4; ++j) { const int col = 4 * lane + 256 * j; const u32x2 ww = w[u][j];
                        const f32x4 vv = (f32x4){hlo(ww.x), hhi(ww.x), hlo(ww.y), hhi(ww.y)} * rstd * *(const f32x4*)(g_final + col); *(f32x4*)(xr + col) = vv; } } }
        }
    }
#undef GRID_BAR
}

extern "C" void kernel_launch(void* const* d_in, const int* in_sizes, int n_in, void* d_out, int out_size, void* d_ws, size_t ws_size, hipStream_t stream) {
    static int grid = 0;
    if (grid == 0) {
        if (n_in != 27 || out_size != (int)OUT_END || ws_size < WS_END) { fprintf(stderr, "kernel_launch: unexpected sizes (n_in %d, out %d, ws %zu; need 27, %zu, >= %zu)\n", n_in, out_size, ws_size, (size_t)OUT_END, (size_t)WS_END); grid = -1; return; }
        int dev = 0, cus = 0, per_cu = 0;
        if (hipGetDevice(&dev) != hipSuccess || hipDeviceGetAttribute(&cus, hipDeviceAttributeMultiprocessorCount, dev) != hipSuccess) { grid = -1; return; }
        if (hipFuncSetAttribute((const void*)fwd_megakernel, hipFuncAttributeMaxDynamicSharedMemorySize, LDS_BYTES) != hipSuccess) { fprintf(stderr, "kernel_launch: hipFuncSetAttribute failed\n"); grid = -1; return; }
        if (hipOccupancyMaxActiveBlocksPerMultiprocessor(&per_cu, (const void*)fwd_megakernel, NTHR, LDS_BYTES) != hipSuccess || per_cu < 1) { fprintf(stderr, "kernel_launch: occupancy query says %d blocks per CU\n", per_cu); per_cu = 1; }
        (void)hipGetLastError();
        grid = cus;
    }
    if (grid < 0) return;
    (void)hipMemsetAsync((char*)d_ws + WS_CTL, 0, CTL_ZERO_BYTES, stream);
    Args a{};
    for (int i = 0; i < 27; ++i) a.in[i] = (const float*)d_in[i];
    a.out = (float*)d_out; a.ws = (unsigned char*)d_ws; a.nphase_lo = 0; a.nphase_hi = 0;
    hipLaunchKernelGGL(fwd_megakernel, dim3(grid), dim3(NTHR), LDS_BYTES, stream, a);
}
```
